# Optimizing an MI355X kernel written in HIP

```python
import math
import jax, jax.numpy as jnp
from jax import lax
import numpy as np

D_MODEL = 1024
BATCH = 1
SEQ = 16384
DEPTH = 2

HEAD_DIM = 64
ROPE_THETA = 10000.0
CONV_WIDTH = 512
DIFF_HEADS = 4
DIFF_V_DIM = 2 * HEAD_DIM
SWA_Q_HEADS = 8
SWA_KV_HEADS = 2
SWA_WINDOW = 128
SWA_BLOCK = 128
Q_BLOCK = 128
N_BRANCH = 3
BRANCH_WIDTH = 512
D_FF = 2816
LN_EPS = 1e-5
ALPHA = (2 * DEPTH) ** 0.25
BETA = (8 * DEPTH) ** -0.25

DIFF_QK = DIFF_HEADS * 2 * HEAD_DIM
DIFF_V = DIFF_HEADS * DIFF_V_DIM
SWA_Q = SWA_Q_HEADS * HEAD_DIM
SWA_KV = SWA_KV_HEADS * HEAD_DIM
SPLIT_SIZES = (CONV_WIDTH, CONV_WIDTH, CONV_WIDTH, DIFF_QK, DIFF_QK, DIFF_V, SWA_Q, SWA_KV, SWA_KV)
D_IN = 3 * CONV_WIDTH + 2 * DIFF_QK + DIFF_V + SWA_Q + 2 * SWA_KV
VALUE_SEGMENTS = (0, 5, 8)

kernel_name = "hybrid_gated_conv_diffattn_swa_encoder"


def layer_norm(x, g, b):
    xf = x.astype(jnp.float32)
    mu = jnp.mean(xf, axis=-1, keepdims=True)
    var = jnp.mean(jnp.square(xf - mu), axis=-1, keepdims=True)
    y = (xf - mu) * lax.rsqrt(var + LN_EPS)
    return (y * g.astype(jnp.float32) + b.astype(jnp.float32)).astype(x.dtype)


def rms_norm(x, g):
    xf = x.astype(jnp.float32)
    y = xf * lax.rsqrt(jnp.mean(jnp.square(xf), axis=-1, keepdims=True) + LN_EPS)
    return (y * g.astype(jnp.float32)).astype(x.dtype)


def dwconv3(x, w):
    xp = jnp.pad(x, ((0, 0), (1, 1), (0, 0)))
    return w[0] * xp[:, :-2] + w[1] * xp[:, 1:-1] + w[2] * xp[:, 2:]


def rope_tables(positions):
    inv_freq = 1.0 / (ROPE_THETA ** (jnp.arange(0, HEAD_DIM, 2, dtype=jnp.float32) / HEAD_DIM))
    ang = positions.astype(jnp.float32)[..., None] * inv_freq
    return jnp.cos(ang), jnp.sin(ang)


def apply_rope(x, cos, sin):
    shape = cos.shape[:2] + (1,) * (x.ndim - 3) + cos.shape[-1:]
    c = cos.reshape(shape).astype(x.dtype)
    s = sin.reshape(shape).astype(x.dtype)
    x1, x2 = jnp.split(x, 2, axis=-1)
    return jnp.concatenate([x1 * c - x2 * s, x2 * c + x1 * s], axis=-1)


def short_conv_mixer(xt, gate_b, gate_c, w):
    return gate_b * dwconv3(gate_c * xt, w)


def diff_attention(q, k, v, lam, subln_g, lambda_init):
    b, s, h = q.shape[:3]
    nb = s // Q_BLOCK
    scale = HEAD_DIM ** -0.5
    qb = q.reshape(b, nb, Q_BLOCK, h, 2, HEAD_DIM).transpose(1, 0, 2, 3, 4, 5)

    def block(qi):
        sc = jnp.einsum('bqhjd,bkhjd->bhjqk', qi, k).astype(jnp.float32) * scale
        p = jax.nn.softmax(sc, axis=-1)
        a = p[:, :, 0] - lam * p[:, :, 1]
        return jnp.einsum('bhqk,bkhe->bqhe', a.astype(v.dtype), v)

    o = lax.map(block, qb)
    o = o.transpose(1, 0, 2, 3, 4).reshape(b, s, h, DIFF_V_DIM)
    o = rms_norm(o, subln_g) * (1.0 - lambda_init)
    return o.reshape(b, s, h * DIFF_V_DIM)


def window_attention(q, k, v, sink):
    b, s = q.shape[:2]
    nb = s // SWA_BLOCK
    g = SWA_Q_HEADS // SWA_KV_HEADS
    qb = q.reshape(b, nb, SWA_BLOCK, SWA_KV_HEADS, g, HEAD_DIM)

    def band(t):
        tp = jnp.pad(t, ((0, 0), (SWA_BLOCK, SWA_BLOCK), (0, 0), (0, 0)))
        tp = tp.reshape(b, nb + 2, SWA_BLOCK, SWA_KV_HEADS, HEAD_DIM)
        return jnp.concatenate([tp[:, :-2], tp[:, 1:-1], tp[:, 2:]], axis=2)

    kb, vb = band(k), band(v)
    sc = jnp.einsum('bnqhgd,bnkhd->bnhgqk', qb, kb).astype(jnp.float32) * (HEAD_DIM ** -0.5)
    qi = jnp.arange(SWA_BLOCK)[:, None]
    kj = jnp.arange(3 * SWA_BLOCK)[None, :]
    in_window = jnp.abs(kj - SWA_BLOCK - qi) <= SWA_WINDOW
    key_pos = (jnp.arange(nb) * SWA_BLOCK)[:, None, None] - SWA_BLOCK + kj[None]
    valid = in_window[None] & (key_pos >= 0) & (key_pos < s)
    sc = jnp.where(valid[None, :, None, None], sc, -jnp.inf)
    sink_l = sink.astype(jnp.float32).reshape(SWA_KV_HEADS, g)[None, None, :, :, None, None]
    m = jnp.maximum(jnp.max(sc, axis=-1, keepdims=True), sink_l)
    e = jnp.exp(sc - m)
    p = e / (jnp.sum(e, axis=-1, keepdims=True) + jnp.exp(sink_l - m))
    o = jnp.einsum('bnhgqk,bnkhd->bnqhgd', p.astype(v.dtype), vb)
    return o.reshape(b, s, SWA_Q_HEADS * HEAD_DIM)


def conv_ffn(x, w_up, conv_w, w_down):
    hdn = dwconv3(x @ w_up, conv_w)
    gate, up = jnp.split(hdn, 2, axis=-1)
    return (jax.nn.gelu(gate, approximate=False) * up) @ w_down


def setup_inputs(seed: int = 0) -> dict:
    key = jax.random.key(seed)
    ks = jax.random.split(key, 24)
    f32 = jnp.float32
    nrm = lambda k, shape, sc: jax.random.normal(k, shape, f32) * sc

    col_scale = np.concatenate([np.full((n,), BETA if i in VALUE_SEGMENTS else 1.0, np.float32)
                                for i, n in enumerate(SPLIT_SIZES)])
    x = jax.random.normal(ks[0], (BATCH, SEQ, D_MODEL), f32)
    positions = jnp.broadcast_to(jnp.arange(SEQ, dtype=jnp.int32), (BATCH, SEQ))
    return {
        "x": x,
        "positions": positions,
        "ln_in_g": 1.0 + nrm(ks[1], (D_MODEL,), 0.02),
        "ln_in_b": nrm(ks[2], (D_MODEL,), 0.02),
        "w_in": nrm(ks[3], (DEPTH, D_MODEL, D_IN), D_MODEL ** -0.5) * jnp.asarray(col_scale),
        "conv_w": nrm(ks[4], (DEPTH, 3, CONV_WIDTH), 3 ** -0.5),
        "diff_lambda": nrm(ks[5], (DEPTH, 4, HEAD_DIM), 0.1),
        "diff_subln_g": 1.0 + nrm(ks[6], (DEPTH, DIFF_V_DIM), 0.02),
        "swa_sink": nrm(ks[7], (DEPTH, SWA_Q_HEADS), 0.5),
        "w_branch_gate": nrm(ks[8], (DEPTH, D_MODEL, N_BRANCH * D_MODEL), D_MODEL ** -0.5),
        "b_branch_gate": nrm(ks[9], (DEPTH, N_BRANCH * D_MODEL), 0.02),
        "w_branch": nrm(ks[10], (DEPTH, N_BRANCH, BRANCH_WIDTH, D_MODEL), BRANCH_WIDTH ** -0.5 * BETA),
        "w_o": nrm(ks[11], (DEPTH, D_MODEL, D_MODEL), D_MODEL ** -0.5 * BETA),
        "ln_mix_g": 1.0 + nrm(ks[12], (DEPTH, D_MODEL), 0.02),
        "ln_mix_b": nrm(ks[13], (DEPTH, D_MODEL), 0.02),
        "w_ffn_up": nrm(ks[14], (DEPTH, D_MODEL, 2 * D_FF), D_MODEL ** -0.5 * BETA),
        "ffn_conv_w": nrm(ks[15], (DEPTH, 3, 2 * D_FF), 3 ** -0.5),
        "w_ffn_down": nrm(ks[16], (DEPTH, D_FF, D_MODEL), D_FF ** -0.5 * BETA),
        "ln_ffn_g": 1.0 + nrm(ks[17], (DEPTH, D_MODEL), 0.02),
        "ln_ffn_b": nrm(ks[18], (DEPTH, D_MODEL), 0.02),
    }


def reference(x, positions, ln_in_g, ln_in_b, w_in, conv_w, diff_lambda, diff_subln_g, swa_sink,
              w_branch_gate, b_branch_gate, w_branch, w_o, ln_mix_g, ln_mix_b,
              w_ffn_up, ffn_conv_w, w_ffn_down, ln_ffn_g, ln_ffn_b):
    b, s, _ = x.shape
    split_at = np.cumsum(SPLIT_SIZES)[:-1].tolist()
    cos, sin = rope_tables(positions)
    h = layer_norm(x, ln_in_g, ln_in_b)
    for l in range(DEPTH):
        lambda_init = 0.8 - 0.6 * math.exp(-0.3 * l)
        proj = h @ w_in[l]
        a_x, a_b, a_c, dq, dk, dv, sq, sk, sv = jnp.split(proj, split_at, axis=-1)

        y_a = short_conv_mixer(a_x, a_b, a_c, conv_w[l])

        dq = apply_rope(dq.reshape(b, s, DIFF_HEADS, 2, HEAD_DIM), cos, sin)
        dk = apply_rope(dk.reshape(b, s, DIFF_HEADS, 2, HEAD_DIM), cos, sin)
        dv = dv.reshape(b, s, DIFF_HEADS, DIFF_V_DIM)
        lp = diff_lambda[l].astype(jnp.float32)
        lam = jnp.exp(jnp.sum(lp[0] * lp[1])) - jnp.exp(jnp.sum(lp[2] * lp[3])) + lambda_init
        y_b = diff_attention(dq, dk, dv, lam, diff_subln_g[l], lambda_init)

        sq = apply_rope(sq.reshape(b, s, SWA_Q_HEADS, HEAD_DIM), cos, sin)
        sk = apply_rope(sk.reshape(b, s, SWA_KV_HEADS, HEAD_DIM), cos, sin)
        sv = sv.reshape(b, s, SWA_KV_HEADS, HEAD_DIM)
        y_c = window_attention(sq, sk, sv, swa_sink[l])

        ys = jnp.stack([y_a, y_b, y_c], axis=2)
        branches = jnp.einsum('bsnc,ncd->bsnd', ys, w_branch[l])
        gates = jax.nn.sigmoid(h @ w_branch_gate[l] + b_branch_gate[l]).reshape(b, s, N_BRANCH, D_MODEL)
        mix = jnp.sum(gates * branches, axis=2) @ w_o[l]
        h = layer_norm(ALPHA * h + mix, ln_mix_g[l], ln_mix_b[l])

        f = conv_ffn(h, w_ffn_up[l], ffn_conv_w[l], w_ffn_down[l])
        h = layer_norm(ALPHA * h + f, ln_ffn_g[l], ln_ffn_b[l])
    return h
```

```cpp
#include <hip/hip_runtime.h>
#include <hip/hip_bf16.h>
#include <cstdio>
#include <cstdint>

#ifndef MK_ONE_LAUNCH
#define MK_ONE_LAUNCH 0
#endif

namespace pg8 {
#define PG8_LAS __attribute__((address_space(3)))
typedef unsigned short bf16_t;
typedef short bf16x8 __attribute__((ext_vector_type(8)));
typedef float f32x4 __attribute__((ext_vector_type(4)));
typedef float f32x2 __attribute__((ext_vector_type(2)));
typedef unsigned u32x4 __attribute__((ext_vector_type(4)));
typedef unsigned u32x2 __attribute__((ext_vector_type(2)));
constexpr int BM = 256, BK = 64, HALF = 128, HTB = HALF * BK * 2  , STAGE_BYTES = 8 * HTB, NXCD = 8, WGM = 8;

__host__ __device__ __forceinline__ int lds_byte(int r, int c) { const int st = (r >> 4) * 2 + (c >> 5), rr = r & 15, cc = c & 31, ob = rr * 64 + cc * 2; return st * 1024 + (ob ^ (((ob >> 9) & 1) << 5)); }
__host__ __device__ __forceinline__ void stage_rc(int b, int& R, int& C) { const int st = b / 1024, sb = b % 1024, swz = sb ^ (((sb >> 9) & 1) << 5); R = (st >> 1) * 16 + swz / 64; C = (st & 1) * 32 + (swz % 64) / 2; }
__host__ __device__ __forceinline__ int perm32(int rho) { const int n = rho >> 4, i = rho & 15; return 8 * (i >> 2) + 4 * n + (i & 3); }

struct Unit { int pm, pn, arow, brow, kofs, seg; };
struct Gemm { const bf16_t* A; const bf16_t* Bt; int lda, ldb, K; };

struct StaticOrder {
    int nM, nN, nwg, G, c, rowstep;
    __device__ void init(int nM_, int nN_, int G_, int c_, int rowstep_) { nM = nM_; nN = nN_; nwg = nM * nN; G = G_; c = c_; rowstep = rowstep_; }
    __device__ bool next(int i, Unit& u) const {
        const long L = (long)i * G + c; if (L >= nwg) return false;
        int wgid = (int)L; { const int q = nwg / NXCD, r = nwg % NXCD, xcd = wgid % NXCD, off = wgid / NXCD; wgid = (xcd < r ? xcd * (q + 1) : r * (q + 1) + (xcd - r) * q) + off; }
        const int nig = WGM * nN, gid = wgid / nig, fm = gid * WGM, gsz = (nM - fm) < WGM ? (nM - fm) : WGM;
        u.pm = fm + ((wgid % nig) % gsz); u.pn = (wgid % nig) / gsz; u.arow = u.pm * rowstep; u.brow = u.pn * BM; u.kofs = 0; u.seg = 0; return true;
    }
};
struct SegOrder {
    StaticOrder so; int nseg, klen;
    __device__ void init(int nM_, int nN_, int G_, int c_, int nseg_, int klen_) { so.init(nM_, nN_, G_, c_, BM); nseg = nseg_; klen = klen_; }
    __device__ bool next(int i, Unit& u) const { const int t = i / nseg, s = i - t * nseg; if (!so.next(t, u)) return false; u.kofs = s * klen; u.seg = s; return true; }
};

typedef __bf16 bf16x2_t __attribute__((ext_vector_type(2)));
__device__ __forceinline__ unsigned cvt_pk_bf16(float lo, float hi) { f32x2 v = {lo, hi}; bf16x2_t b = __builtin_convertvector(v, bf16x2_t); return __builtin_bit_cast(unsigned, b); }
__device__ __forceinline__ float bf_lo(unsigned w) { return __uint_as_float(w << 16); }
__device__ __forceinline__ float bf_hi(unsigned w) { return __uint_as_float(w & 0xffff0000u); }
__device__ __forceinline__ u32x4 pack8(const f32x4 a, const f32x4 b) { u32x4 w; w.x = cvt_pk_bf16(a[0], a[1]); w.y = cvt_pk_bf16(a[2], a[3]); w.z = cvt_pk_bf16(b[0], b[1]); w.w = cvt_pk_bf16(b[2], b[3]); return w; }
__device__ __forceinline__ void unpack8(const u32x4 w, f32x4& a, f32x4& b) { a = (f32x4){bf_lo(w.x), bf_hi(w.x), bf_lo(w.y), bf_hi(w.y)}; b = (f32x4){bf_lo(w.z), bf_hi(w.z), bf_lo(w.w), bf_hi(w.w)}; }
__device__ __forceinline__ f32x2 gelu_pk(f32x2 v) {
    const f32x2 av = __builtin_elementwise_abs(v), d = av * 0.2316418882f + 1.0f;
    f32x2 t; t.x = __builtin_amdgcn_rcpf(d.x); t.y = __builtin_amdgcn_rcpf(d.y);
    f32x2 q = t * 0.5307027145f + (-0.7265760135f); q = q * t + 0.7107068705f; q = q * t + (-0.142248368f); q = q * t + 0.127414796f; q = q * t;
    const f32x2 s = (v * v) * (-0.72134752044f);
    f32x2 e; e.x = __builtin_amdgcn_exp2f(s.x); e.y = __builtin_amdgcn_exp2f(s.y);
    const f32x2 m = v * (q * e), r = v - m;
    f32x2 o; o.x = v.x < 0.f ? m.x : r.x; o.y = v.y < 0.f ? m.y : r.y; return o;
}
__device__ __forceinline__ f32x4 gelu4(f32x4 v) { f32x2 a = gelu_pk((f32x2){v[0], v[1]}), b = gelu_pk((f32x2){v[2], v[3]}); return (f32x4){a.x, a.y, b.x, b.y}; }

template <class Epi, class Sched, bool ALIGN_EPI>
__device__ __forceinline__ void gemm_phase(const int tid, PG8_LAS unsigned char* lds, PG8_LAS unsigned char* xlds, const Gemm g, const Sched& S, const Epi& E) {
    const int wid = __builtin_amdgcn_readfirstlane(tid >> 6), lane = tid & 63, wr = wid >> 2, wc = wid & 3, fr = lane & 15, fq = lane >> 4;
    const int K = g.K, nt = K / BK;
    unsigned voffA[2], voffB[2];
#pragma unroll
    for (int i = 0; i < 2; ++i) { int R, C; stage_rc(tid * 16 + i * 8192, R, C); const int Rb = Epi::PERM ? ((R & ~31) + perm32(R & 31)) : R;
        voffA[i] = (unsigned)(R * g.lda + C) * 2u; voffB[i] = (unsigned)(Rb * g.ldb + C) * 2u; }
    const size_t kstep = (size_t)(BK * 2);
    const size_t hstepA = (size_t)HALF * g.lda * 2, hstepB = (size_t)HALF * g.ldb * 2;
    const unsigned ldsw = (unsigned)wid * 1024u;
    const int aoff = lds_byte(wr * 64 + fr, fq * 8), boff = lds_byte(wc * 32 + fr, fq * 8);
#define PG8_SA(b, h) (((b) * 2 + (h)) * HTB)
#define PG8_SB(b, h) ((4 + (b) * 2 + (h)) * HTB)
#define PG8_STAGE(bufoff, gbase, voff) do { _Pragma("unroll") for (int _i = 0; _i < 2; ++_i) \
        __builtin_amdgcn_global_load_lds((const unsigned*)((const char*)(gbase) + (voff)[_i]), (PG8_LAS unsigned*)(lds + (bufoff) + ldsw + _i * 8192), 16, 0, 0); } while (0)
#define PG8_LDA(dst, b, h) do { _Pragma("unroll") for (int m = 0; m < 4; ++m) _Pragma("unroll") for (int k = 0; k < 2; ++k) dst[m][k] = *(const PG8_LAS bf16x8*)(lds + PG8_SA(b, h) + aoff + m * 2048 + k * 1024); } while (0)
#define PG8_LDB(dst, b, h) do { _Pragma("unroll") for (int n = 0; n < 2; ++n) _Pragma("unroll") for (int k = 0; k < 2; ++k) dst[n][k] = *(const PG8_LAS bf16x8*)(lds + PG8_SB(b, h) + boff + n * 2048 + k * 1024); } while (0)
#define PG8_MMA(ai, bj, At, Bt) do { __builtin_amdgcn_s_setprio(1); _Pragma("unroll") for (int m = 0; m < 4; ++m) _Pragma("unroll") for (int n = 0; n < 2; ++n) _Pragma("unroll") for (int k = 0; k < 2; ++k) \
        acc[ai][bj][m][n] = __builtin_amdgcn_mfma_f32_16x16x32_bf16(Bt[n][k], At[m][k], acc[ai][bj][m][n], 0, 0, 0); __builtin_amdgcn_s_setprio(0); } while (0)
#define PG8_WAIT_V(n) asm volatile("s_waitcnt vmcnt(" #n ")" ::: "memory")
#define PG8_WAIT_L(n) asm volatile("s_waitcnt lgkmcnt(" #n ")" ::: "memory")
#define PG8_BAR __builtin_amdgcn_s_barrier()
#define PG8_SCHED __builtin_amdgcn_sched_barrier(0)
    Unit cur, nxt; int ui = 0;
    if (!S.next(0, cur)) return;
    f32x4 acc[2][2][4][2];
#pragma unroll
    for (int a = 0; a < 2; ++a)
#pragma unroll
        for (int b = 0; b < 2; ++b)
#pragma unroll
            for (int m = 0; m < 4; ++m)
#pragma unroll
                for (int n = 0; n < 2; ++n) acc[a][b][m][n] = (f32x4){0.f, 0.f, 0.f, 0.f};
    bf16x8 At[4][2], B0[2][2], B1[2][2];
    const char* cA = (const char*)g.A + ((size_t)cur.arow * g.lda + cur.kofs) * 2; const char* cB = (const char*)g.Bt + ((size_t)cur.brow * g.ldb + cur.kofs) * 2;
    PG8_STAGE(PG8_SB(0, 0), cB, voffB); PG8_STAGE(PG8_SB(0, 1), cB + hstepB, voffB); PG8_STAGE(PG8_SA(0, 0), cA, voffA); PG8_STAGE(PG8_SA(0, 1), cA + hstepA, voffA);
    if (wr == 1) PG8_BAR;
    PG8_WAIT_V(2); PG8_BAR;
    PG8_STAGE(PG8_SB(1, 0), cB + kstep, voffB); PG8_STAGE(PG8_SA(1, 0), cA + kstep, voffA); PG8_STAGE(PG8_SB(1, 1), cB + hstepB + kstep, voffB);
    PG8_WAIT_V(6); PG8_BAR;
    for (;;) {
        const bool has_next = S.next(ui + 1, nxt);
        const char* nA = has_next ? (const char*)g.A + ((size_t)nxt.arow * g.lda + nxt.kofs) * 2 : cA; const char* nB = has_next ? (const char*)g.Bt + ((size_t)nxt.brow * g.ldb + nxt.kofs) * 2 : cB;
        for (int t = 0; t < nt; t += 2) {
            const bool last = (t == nt - 2);
            const char* a1 = cA + (size_t)(t + 1) * kstep;
            const char* a2 = last ? nA : cA + (size_t)(t + 2) * kstep; const char* b2 = last ? nB : cB + (size_t)(t + 2) * kstep;
            const char* a3 = a2 + kstep; const char* b3 = b2 + kstep;
            PG8_LDB(B0, 0, 0); PG8_LDB(B1, 0, 1); PG8_SCHED; PG8_LDA(At, 0, 0); PG8_STAGE(PG8_SA(1, 1), a1 + hstepA, voffA);
            PG8_WAIT_V(8); PG8_WAIT_L(0); PG8_BAR; PG8_MMA(0, 0, At, B0); PG8_MMA(0, 1, At, B1); PG8_BAR; PG8_SCHED;
            PG8_LDA(At, 0, 1); PG8_STAGE(PG8_SB(0, 0), b2, voffB); PG8_STAGE(PG8_SB(0, 1), b2 + hstepB, voffB); PG8_STAGE(PG8_SA(0, 0), a2, voffA);
            PG8_WAIT_V(8); PG8_WAIT_L(0); PG8_BAR; PG8_MMA(1, 0, At, B0); PG8_MMA(1, 1, At, B1); PG8_BAR; PG8_SCHED;
            PG8_LDB(B0, 1, 0); PG8_LDB(B1, 1, 1); PG8_SCHED; PG8_LDA(At, 1, 0); PG8_STAGE(PG8_SA(0, 1), a2 + hstepA, voffA);
            PG8_WAIT_V(8); PG8_WAIT_L(0); PG8_BAR; PG8_MMA(0, 0, At, B0); PG8_MMA(0, 1, At, B1); PG8_BAR; PG8_SCHED;
            PG8_LDA(At, 1, 1); PG8_STAGE(PG8_SB(1, 0), b3, voffB); PG8_STAGE(PG8_SB(1, 1), b3 + hstepB, voffB); PG8_STAGE(PG8_SA(1, 0), a3, voffA);
            PG8_WAIT_V(8); PG8_WAIT_L(0); PG8_BAR; PG8_MMA(1, 0, At, B0); PG8_MMA(1, 1, At, B1); PG8_BAR; PG8_SCHED;
        }
        if constexpr (ALIGN_EPI) { if (wr == 0) PG8_BAR; }
        if constexpr (!Epi::AFTER_DRAIN) { E(acc, cur, wr, wc, fr, fq, xlds, wid, lane); }
        if (!has_next) break;
#pragma unroll
        for (int a = 0; a < 2; ++a)
#pragma unroll
            for (int b = 0; b < 2; ++b)
#pragma unroll
                for (int m = 0; m < 4; ++m)
#pragma unroll
                    for (int n = 0; n < 2; ++n) acc[a][b][m][n] = (f32x4){0.f, 0.f, 0.f, 0.f};
        cur = nxt; cA = nA; cB = nB; ++ui;
        if constexpr (ALIGN_EPI) { if (wr == 1) PG8_BAR; }
    }
    PG8_WAIT_V(0);
    if constexpr (!ALIGN_EPI) { if (wr == 0) PG8_BAR; }
    PG8_BAR;
    if constexpr (Epi::AFTER_DRAIN) { E.fused(acc, cur, wr, wc, fr, fq, lds, wid, lane); }
#undef PG8_SA
#undef PG8_SB
#undef PG8_STAGE
#undef PG8_LDA
#undef PG8_LDB
#undef PG8_MMA
#undef PG8_WAIT_V
#undef PG8_WAIT_L
#undef PG8_BAR
#undef PG8_SCHED
}

typedef const f32x4 (&AccRef)[2][2][4][2];
#define PG8_EPI_ARGS AccRef acc, const Unit& u, int wr, int wc, int fr, int fq, PG8_LAS unsigned char* xlds, int wid, int lane

struct EpiInProj {
    static constexpr bool PERM = true, AFTER_DRAIN = false;
    bf16_t *U, *YS, *DK, *DV, *SK, *SV; const float *cs, *sn;
    __device__ __forceinline__ void operator()(PG8_EPI_ARGS) const {
        const int pn = u.pn, row0 = u.pm * BM + wr * 64 + fr;
        int kind, ld, d0, d1; bf16_t* base;
        if (pn < 4)       { kind = 0; base = U;  ld = 512;  d0 = 128 * pn + 32 * wc + 8 * fq; d1 = 0; }
        else if (pn < 6)  { kind = 1; base = YS; ld = 1536; d0 = (pn - 4) * 256 + 32 * wc + 8 * fq; d1 = d0 + 128; }
        else if (pn < 8)  { kind = 2; base = YS; ld = 1536; d0 = 512 + (4 * (pn - 6) + wc) * 64 + 8 * fq; d1 = d0 + 32; }
        else if (pn < 10) { kind = 2; base = DK; ld = 512;  d0 = (4 * (pn - 8) + wc) * 64 + 8 * fq; d1 = d0 + 32; }
        else if (pn < 12) { kind = 1; base = DV; ld = 512;  d0 = (pn - 10) * 256 + 32 * wc + 8 * fq; d1 = d0 + 128; }
        else if (pn < 14) { kind = 2; base = YS; ld = 1536; d0 = 1024 + (4 * (pn - 12) + wc) * 64 + 8 * fq; d1 = d0 + 32; }
        else if (wc < 2)  { kind = 2; base = SK; ld = 128;  d0 = wc * 64 + 8 * fq; d1 = d0 + 32; }
        else              { kind = 1; base = SV; ld = 128;  d0 = 32 * (wc - 2) + 8 * fq; d1 = d0 + 64; }
#pragma unroll
        for (int ai = 0; ai < 2; ++ai)
#pragma unroll
            for (int m = 0; m < 4; ++m) {
                const int row = row0 + ai * HALF + m * 16;
                bf16_t* rp = base + (size_t)row * ld;
                const f32x4 x0a = acc[ai][0][m][0], x0b = acc[ai][0][m][1], x1a = acc[ai][1][m][0], x1b = acc[ai][1][m][1];
                if (kind == 0) { *(u32x4*)(rp + d0) = pack8(x0a * x1a, x0b * x1b); }
                else if (kind == 1) { *(u32x4*)(rp + d0) = pack8(x0a, x0b); *(u32x4*)(rp + d1) = pack8(x1a, x1b); }
                else {
                    const f32x4 ca = *(const f32x4*)(cs + (size_t)row * 32 + 8 * fq), cb = *(const f32x4*)(cs + (size_t)row * 32 + 8 * fq + 4);
                    const f32x4 sa = *(const f32x4*)(sn + (size_t)row * 32 + 8 * fq), sb = *(const f32x4*)(sn + (size_t)row * 32 + 8 * fq + 4);
                    *(u32x4*)(rp + d0) = pack8(x0a * ca - x1a * sa, x0b * cb - x1b * sb);
                    *(u32x4*)(rp + d1) = pack8(x1a * ca + x0a * sa, x1b * cb + x0b * sb);
                }
            }
    }
};

struct EpiGates {
    static constexpr bool PERM = true, AFTER_DRAIN = false;
    bf16_t* G; const float* bias;
    __device__ __forceinline__ void operator()(PG8_EPI_ARGS) const {
        const int row0 = u.pm * BM + wr * 64 + fr, col0 = u.pn * BM + wc * 32 + 8 * fq;
        f32x4 bv[2][2];
#pragma unroll
        for (int bj = 0; bj < 2; ++bj)
#pragma unroll
            for (int n = 0; n < 2; ++n) bv[bj][n] = *(const f32x4*)(bias + col0 + bj * HALF + 4 * n);
#pragma unroll
        for (int ai = 0; ai < 2; ++ai)
#pragma unroll
            for (int m = 0; m < 4; ++m) { bf16_t* rp = G + (size_t)(row0 + ai * HALF + m * 16) * 3072 + col0;
#pragma unroll
                for (int bj = 0; bj < 2; ++bj) { f32x4 v[2];
#pragma unroll
                    for (int n = 0; n < 2; ++n) { const f32x4 x = acc[ai][bj][m][n] + bv[bj][n];
#pragma unroll
                        for (int e = 0; e < 4; ++e) v[n][e] = __builtin_amdgcn_rcpf(1.0f + __builtin_amdgcn_exp2f(x[e] * -1.4426950408889634f)); }
                    *(u32x4*)(rp + bj * HALF) = pack8(v[0], v[1]); } }
    }
};

struct EpiBranch {
    static constexpr bool PERM = true, AFTER_DRAIN = false;
    bf16_t* O; const bf16_t* GT;
    __device__ __forceinline__ void operator()(PG8_EPI_ARGS) const {
        const int row0 = u.pm * BM + wr * 64 + fr, col0 = u.pn * BM + wc * 32 + 8 * fq, seg = u.seg;
#pragma unroll
        for (int ai = 0; ai < 2; ++ai)
#pragma unroll
            for (int m = 0; m < 4; ++m) { const int row = row0 + ai * HALF + m * 16;
#pragma unroll
                for (int bj = 0; bj < 2; ++bj) {
                    const u32x4 gw = *(const u32x4*)(GT + (size_t)row * 3072 + seg * 1024 + col0 + bj * HALF);
                    f32x4 ga, gb; unpack8(gw, ga, gb);
                    f32x4 va = ga * acc[ai][bj][m][0], vb = gb * acc[ai][bj][m][1];
                    bf16_t* op = O + (size_t)row * 1024 + col0 + bj * HALF;
                    if (seg > 0) { const u32x4 pw = *(const u32x4*)op; f32x4 pa, pb; unpack8(pw, pa, pb); va += pa; vb += pb; }
                    *(u32x4*)op = pack8(va, vb); } }
    }
};

struct EpiResid {
    static constexpr bool PERM = true, AFTER_DRAIN = false;
    float* H; float alpha;
    __device__ __forceinline__ void operator()(PG8_EPI_ARGS) const {
        const int row0 = u.pm * BM + wr * 64 + fr, col0 = u.pn * BM + wc * 32 + 8 * fq;
#pragma unroll
        for (int ai = 0; ai < 2; ++ai)
#pragma unroll
            for (int m = 0; m < 4; ++m) { float* rp = H + (size_t)(row0 + ai * HALF + m * 16) * 1024 + col0;
#pragma unroll
                for (int bj = 0; bj < 2; ++bj)
#pragma unroll
                    for (int n = 0; n < 2; ++n) { f32x4* p = (f32x4*)(rp + bj * HALF + 4 * n); const f32x4 h = *p; *p = h * alpha + acc[ai][bj][m][n]; } }
    }
};

__device__ __forceinline__ float dpp_ror1(float v)  { return __int_as_float(__builtin_amdgcn_update_dpp(0, __float_as_int(v), 0x121, 0xf, 0xf, false)); }
__device__ __forceinline__ float dpp_ror15(float v) { return __int_as_float(__builtin_amdgcn_update_dpp(0, __float_as_int(v), 0x12F, 0xf, 0xf, false)); }
__device__ __forceinline__ f32x4 ror1_4(f32x4 v)  { return (f32x4){dpp_ror1(v[0]), dpp_ror1(v[1]), dpp_ror1(v[2]), dpp_ror1(v[3])}; }
__device__ __forceinline__ f32x4 ror15_4(f32x4 v) { return (f32x4){dpp_ror15(v[0]), dpp_ror15(v[1]), dpp_ror15(v[2]), dpp_ror15(v[3])}; }
struct EpiUpConv {
    static constexpr bool PERM = true, AFTER_DRAIN = false;
    bf16_t* ACT; const float* cw;
    static constexpr int S = 16384;
    __device__ __forceinline__ void operator()(AccRef acc, const Unit& u, int wr_, int wc_, int fr_, int fq_, PG8_LAS unsigned char* xlds, int wid_, int lane_) const {
        int ln; asm volatile("v_mbcnt_lo_u32_b32 %0, -1, 0\n\tv_mbcnt_hi_u32_b32 %0, -1, %0" : "=v"(ln));
        int wid = wid_; asm volatile("" : "+s"(wid));
        const int fr = ln & 15, fq = ln >> 4, wr = wid >> 2, wc = wid & 3;
        (void)wr_; (void)wc_; (void)fr_; (void)fq_; (void)lane_;
        PG8_LAS f32x4* X = (PG8_LAS f32x4*)xlds;
        if (fr == 0) {
#pragma unroll
            for (int ai = 0; ai < 2; ++ai)
#pragma unroll
                for (int bj = 0; bj < 2; ++bj)
#pragma unroll
                    for (int n = 0; n < 2; ++n) X[((((wid * 2 + ai) * 2 + 0) * 2 + bj) * 2 + n) * 4 + fq] = acc[ai][bj][0][n];
        }
        if (fr == 15) {
#pragma unroll
            for (int ai = 0; ai < 2; ++ai)
#pragma unroll
                for (int bj = 0; bj < 2; ++bj)
#pragma unroll
                    for (int n = 0; n < 2; ++n) X[((((wid * 2 + ai) * 2 + 1) * 2 + bj) * 2 + n) * 4 + fq] = acc[ai][bj][3][n];
        }
        asm volatile("s_waitcnt lgkmcnt(0)" ::: "memory"); __builtin_amdgcn_s_barrier(); asm volatile("" ::: "memory");
        const int pw = (1 - wr) * 4 + wc;
        const bool f0 = (fr == 0), f15 = (fr == 15);
        const int ubr = S - 254 * u.pm - 1; const unsigned ub = (unsigned)(ubr < 253 ? ubr : 253);
#pragma unroll
        for (int ai = 0; ai < 2; ++ai) {
            const int aip = (ai == 0) ? 0 : wr, ain = (ai == 0) ? wr : 1;
            const bool pvalid = !(ai == 0 && wr == 0), nvalid = !(ai == 1 && wr == 1);
#pragma unroll
            for (int n = 0; n < 2; ++n) {
                asm volatile("" ::: "memory");
                int zr = 0; asm volatile("" : "+v"(zr));
                const int colg = 128 * u.pn + 32 * wc + 8 * fq + 4 * n;
                const float* wp = cw + colg;
                const f32x4 g0 = *(const f32x4*)(wp), g1 = *(const f32x4*)(wp + 5632), g2 = *(const f32x4*)(wp + 2 * 5632);
                const f32x4 u0 = *(const f32x4*)(wp + 2816), u1 = *(const f32x4*)(wp + 2816 + 5632), u2 = *(const f32x4*)(wp + 2816 + 2 * 5632);
                f32x4 hpg = X[((((pw * 2 + aip) * 2 + 1) * 2 + 0) * 2 + n) * 4 + fq], hpu = X[((((pw * 2 + aip) * 2 + 1) * 2 + 1) * 2 + n) * 4 + fq];
                f32x4 hng = X[((((pw * 2 + ain) * 2 + 0) * 2 + 0) * 2 + n) * 4 + fq], hnu = X[((((pw * 2 + ain) * 2 + 0) * 2 + 1) * 2 + n) * 4 + fq];
                if (!pvalid) { hpg = (f32x4){0.f, 0.f, 0.f, 0.f}; hpu = hpg; }
                if (!nvalid) { hng = (f32x4){0.f, 0.f, 0.f, 0.f}; hnu = hng; }
                f32x4 rpg = hpg, rpu = hpu, rcg = ror15_4(acc[ai][0][0][n]), rcu = ror15_4(acc[ai][1][0][n]);
#pragma unroll
                for (int m = 0; m < 4; ++m) {
                    const f32x4 xg = acc[ai][0][m][n], xu = acc[ai][1][m][n];
                    const f32x4 rrg = ror1_4(xg), rru = ror1_4(xu);
                    f32x4 rng = hng, rnu = hnu; if (m < 3) { rng = ror15_4(acc[ai][0][m + 1][n]); rnu = ror15_4(acc[ai][1][m + 1][n]); }
                    f32x4 pg, ng, pu, nu;
#pragma unroll
                    for (int e = 0; e < 4; ++e) { pg[e] = f0 ? rpg[e] : rrg[e]; ng[e] = f15 ? rng[e] : rcg[e]; pu[e] = f0 ? rpu[e] : rru[e]; nu[e] = f15 ? rnu[e] : rcu[e]; }
                    const f32x4 yg = g0 * pg + g1 * xg + g2 * ng, yu = u0 * pu + u1 * xu + u2 * nu;
                    rpg = rrg; rpu = rru; rcg = rng; rcu = rnu;
                    const int r = ai * HALF + wr * 64 + m * 16 + fr + zr, grow = 254 * u.pm - 1 + r;
                    const f32x4 a = gelu4(yg) * yu;
                    u32x2 w; w.x = cvt_pk_bf16(a[0], a[1]); w.y = cvt_pk_bf16(a[2], a[3]);
                    if ((unsigned)(r - 1) <= ub) *(u32x2*)(ACT + (size_t)grow * 2816 + colg) = w;
                }
            }
        }
    }
};
}

namespace att {
typedef unsigned short bf16_t;
using bf16x8 = __attribute__((ext_vector_type(8))) short;
using s16x4  = __attribute__((ext_vector_type(4))) short;
using f32x16 = __attribute__((ext_vector_type(16))) float;
using u32x4  = __attribute__((ext_vector_type(4))) unsigned;
using u32x2  = __attribute__((ext_vector_type(2))) unsigned;
constexpr int NW = 8, QBLK = 32, KVBLK = 64;
constexpr int SHM_V = KVBLK * 128 * 2, SHM_K = KVBLK * 64 * 2, SHM_ATTN = 2 * SHM_V + 2 * SHM_K;
constexpr float SCALE = 0.125f;
constexpr float CEXP = SCALE * 1.4426950408889634f;
constexpr float THR = 8.f;
#define KSWZ64(row, cb) ((row) * 128 + ((cb) ^ ((((row) >> 1) & 7) << 4)))
#define ATT_SBAR() __builtin_amdgcn_sched_barrier(0)
__device__ __forceinline__ int crow(int r, int hi) { return (r & 3) + 8 * (r >> 2) + 4 * hi; }
__device__ __forceinline__ unsigned cvtpk(float lo, float hi) { return pg8::cvt_pk_bf16(lo, hi); }

template <bool MASK>
__device__ __forceinline__ void partialSM(f32x16& p0, f32x16& p1, float& m_reg, float& mn, float& alpha, int dq, int hi, int win) {
  if (MASK) {
#pragma unroll
    for (int r = 0; r < 16; ++r) { const int d0 = dq + crow(r, hi), d1 = d0 + 32;
      if (d0 > win || d0 < -win) p0[r] = -INFINITY; if (d1 > win || d1 < -win) p1[r] = -INFINITY; }
  }
  float pmax = p0[0];
#pragma unroll
  for (int r = 1; r < 16; ++r) pmax = fmaxf(pmax, p0[r]);
#pragma unroll
  for (int r = 0; r < 16; ++r) pmax = fmaxf(pmax, p1[r]);
  { auto rr = __builtin_amdgcn_permlane32_swap(__float_as_uint(pmax), __float_as_uint(pmax), false, false);
    pmax = fmaxf(__uint_as_float(rr[0]), __uint_as_float(rr[1])); }
  if (__builtin_expect(__all(pmax - m_reg <= THR / SCALE), 1)) { mn = m_reg; alpha = 1.f; }
  else { mn = fmaxf(m_reg, pmax); alpha = __builtin_amdgcn_exp2f((m_reg - mn) * CEXP); m_reg = mn; }
  const float mnC = -mn * CEXP;
#pragma unroll
  for (int r = 0; r < 16; ++r) p0[r] = fmaf(p0[r], CEXP, mnC);
#pragma unroll
  for (int r = 0; r < 16; ++r) p1[r] = fmaf(p1[r], CEXP, mnC);
#pragma unroll
  for (int r = 0; r < 16; ++r) p0[r] = __builtin_amdgcn_exp2f(p0[r]);
}
__device__ __forceinline__ void finishSM(f32x16& p0, f32x16& p1, float alpha, float& l_reg, bf16x8& pa0, bf16x8& pa1, bf16x8& pa2, bf16x8& pa3) {
#pragma unroll
  for (int r = 0; r < 16; ++r) p1[r] = __builtin_amdgcn_exp2f(p1[r]);
  float ps = 0;
#pragma unroll
  for (int r = 0; r < 16; ++r) ps += p0[r];
#pragma unroll
  for (int r = 0; r < 16; ++r) ps += p1[r];
  { auto rr = __builtin_amdgcn_permlane32_swap(__float_as_uint(ps), __float_as_uint(ps), false, false);
    ps = __uint_as_float(rr[0]) + __uint_as_float(rr[1]); }
  l_reg = l_reg * alpha + ps;
#define ATT_PK4(P, BASE, OUT) do { unsigned a0 = cvtpk(P[BASE + 0], P[BASE + 1]), a1 = cvtpk(P[BASE + 2], P[BASE + 3]);   \
    unsigned b0 = cvtpk(P[BASE + 4], P[BASE + 5]), b1 = cvtpk(P[BASE + 6], P[BASE + 7]);                              \
    auto r0 = __builtin_amdgcn_permlane32_swap(a0, b0, false, false); auto r1 = __builtin_amdgcn_permlane32_swap(a1, b1, false, false); \
    u32x4 w = {r0[0], r1[0], r0[1], r1[1]}; OUT = *reinterpret_cast<bf16x8*>(&w); } while (0)
  ATT_PK4(p0, 0, pa0); ATT_PK4(p0, 8, pa1); ATT_PK4(p1, 0, pa2); ATT_PK4(p1, 8, pa3);
#undef ATT_PK4
}
__device__ __forceinline__ void qkt(f32x16& p0, f32x16& p1, const char* Ks, const bf16x8* qr, int r32, int hi) {
  p0 = f32x16{}; p1 = f32x16{};
#pragma unroll
  for (int d0 = 0; d0 < 4; ++d0) { const int cb = (d0 * 16 + hi * 8) * 2;
    const bf16x8 b0 = *reinterpret_cast<const bf16x8*>(Ks + KSWZ64(r32, cb));
    const bf16x8 b1 = *reinterpret_cast<const bf16x8*>(Ks + KSWZ64(32 + r32, cb));
    p0 = __builtin_amdgcn_mfma_f32_32x32x16_bf16(b0, qr[d0], p0, 0, 0, 0);
    p1 = __builtin_amdgcn_mfma_f32_32x32x16_bf16(b1, qr[d0], p1, 0, 0, 0); }
}
__device__ __forceinline__ int v_st(int k, int c) { const int kk = (k & ~0xC) | ((k & 4) << 1) | ((k & 8) >> 1); return ((kk >> 3) * 4 + (c >> 5)) * 512 + ((kk & 7) * 32 + (c & 31)) * 2; }
__device__ __forceinline__ int v_rd_base(int lane) { return ((lane & 3) << 3) | (((lane >> 2) & 3) << 6) | (((lane >> 4) & 1) << 5) | (((lane >> 5) & 1) << 8); }
constexpr int v_rd_off(int d0, int ks, int half) { return d0 * 512 + ks * 4096 + half * 2048; }
template <int OFF> __device__ __forceinline__ s16x4 tr_read(int vb) {
  s16x4 r; asm volatile("ds_read_b64_tr_b16 %0, %1 offset:%2" : "=&v"(r) : "v"(vb), "i"(OFF) : "memory"); return r;
}
template <int D0> __device__ __forceinline__ void pv_one(f32x16& od, int vb, bf16x8 pa0, bf16x8 pa1, bf16x8 pa2, bf16x8 pa3) {
  const s16x4 l0 = tr_read<v_rd_off(D0, 0, 0)>(vb), h0 = tr_read<v_rd_off(D0, 0, 1)>(vb), l1 = tr_read<v_rd_off(D0, 1, 0)>(vb), h1 = tr_read<v_rd_off(D0, 1, 1)>(vb);
  const s16x4 l2 = tr_read<v_rd_off(D0, 2, 0)>(vb), h2 = tr_read<v_rd_off(D0, 2, 1)>(vb), l3 = tr_read<v_rd_off(D0, 3, 0)>(vb), h3 = tr_read<v_rd_off(D0, 3, 1)>(vb);
  asm volatile("s_waitcnt lgkmcnt(0)" ::: "memory"); ATT_SBAR();
#define ATT_PK(L, H) (bf16x8){L[0], L[1], L[2], L[3], H[0], H[1], H[2], H[3]}
  od = __builtin_amdgcn_mfma_f32_32x32x16_bf16(ATT_PK(l0, h0), pa0, od, 0, 0, 0);
  od = __builtin_amdgcn_mfma_f32_32x32x16_bf16(ATT_PK(l1, h1), pa1, od, 0, 0, 0);
  od = __builtin_amdgcn_mfma_f32_32x32x16_bf16(ATT_PK(l2, h2), pa2, od, 0, 0, 0);
  od = __builtin_amdgcn_mfma_f32_32x32x16_bf16(ATT_PK(l3, h3), pa3, od, 0, 0, 0);
#undef ATT_PK
}
template <int DV> __device__ __forceinline__ void pv_all(f32x16* o, int vb, bf16x8 pa0, bf16x8 pa1, bf16x8 pa2, bf16x8 pa3) {
  pv_one<0>(o[0], vb, pa0, pa1, pa2, pa3); pv_one<1>(o[1], vb, pa0, pa1, pa2, pa3);
  if constexpr (DV == 128) { pv_one<2>(o[2], vb, pa0, pa1, pa2, pa3); pv_one<3>(o[3], vb, pa0, pa1, pa2, pa3); }
}

template <int DV, bool MASK, int SDEPTH, int ldk, int ldv>
__device__ __forceinline__ void attn_core(const int tid, const bf16_t* __restrict__ Qw, const bf16_t* __restrict__ Kh, const bf16_t* __restrict__ Vh, int NT,
                                          float m_init, float l_init, int dq0, int win, char* lds, f32x16 (&o)[DV / 32], float& l_out) {
  const int lane = tid & 63, r32 = lane & 31, hi = lane >> 5;
  char* V_lds = lds; char* K_lds = lds + 2 * SHM_V;
  float m_reg = m_init, l_reg = l_init;
#pragma unroll
  for (int d = 0; d < DV / 32; ++d) o[d] = f32x16{};
  bf16x8 qr[4];
#pragma unroll
  for (int d0 = 0; d0 < 4; ++d0) qr[d0] = *reinterpret_cast<const bf16x8*>(Qw + d0 * 16);
  const int kr = tid >> 3, kc8 = (tid & 7) * 8, kdst = KSWZ64(kr, kc8 * 2);
  const int sr = (DV == 128) ? (tid >> 4) : (tid >> 3), sc = (DV == 128) ? (tid & 15) * 8 : (tid & 7) * 8;
  const int vst0 = v_st(sr, sc), vst1 = v_st(32 + sr, sc);
  const int vb0 = (int)(uintptr_t)V_lds + v_rd_base(lane);
  struct { bf16x8 ks, vs0, vs1; } sr_[SDEPTH];
#define ATT_SLOAD(i, k0) do { sr_[i].ks = *reinterpret_cast<const bf16x8*>(Kh + (size_t)((k0) + kr) * ldk + kc8); \
    sr_[i].vs0 = *reinterpret_cast<const bf16x8*>(Vh + (size_t)((k0) + sr) * ldv + sc); \
    if constexpr (DV == 128) sr_[i].vs1 = *reinterpret_cast<const bf16x8*>(Vh + (size_t)((k0) + 32 + sr) * ldv + sc); } while (0)
#define ATT_SWRITE(b, i) do { *(bf16x8*)(K_lds + (b) * SHM_K + kdst) = sr_[i].ks; *(bf16x8*)(V_lds + (b) * SHM_V + vst0) = sr_[i].vs0; \
    if constexpr (DV == 128) *(bf16x8*)(V_lds + (b) * SHM_V + vst1) = sr_[i].vs1; } while (0)
#define ATT_SWAIT() do { if constexpr (SDEPTH == 1) asm volatile("s_waitcnt vmcnt(0)" ::: "memory"); else if constexpr (DV == 128) asm volatile("s_waitcnt vmcnt(3)" ::: "memory"); else asm volatile("s_waitcnt vmcnt(2)" ::: "memory"); } while (0)
#define ATT_RESC(a) do { if (__any((a) < 1.f)) { _Pragma("unroll") for (int d = 0; d < DV / 32; ++d) _Pragma("unroll") for (int r = 0; r < 16; ++r) o[d][r] *= (a); } } while (0)
  f32x16 pA0, pA1, pB0, pB1; float mnA, mnB, alA, alB; bf16x8 pa0, pa1, pa2, pa3;
  constexpr int SE = 0, SO = SDEPTH - 1;
  ATT_SLOAD(SE, 0); asm volatile("s_waitcnt vmcnt(0)" ::: "memory"); ATT_SWRITE(0, SE); __syncthreads();
  qkt(pA0, pA1, K_lds, qr, r32, hi); partialSM<MASK>(pA0, pA1, m_reg, mnA, alA, dq0, hi, win);
  ATT_SLOAD(SO, KVBLK); if constexpr (SDEPTH == 2) { if (2 < NT) ATT_SLOAD(SE, 2 * KVBLK); }
  ATT_SWAIT(); ATT_SWRITE(1, SO); __syncthreads();
  ATT_RESC(alA);
  for (int j = 1; j + 1 < NT; j += 2) {
    ATT_SBAR(); qkt(pB0, pB1, K_lds + SHM_K, qr, r32, hi);
    finishSM(pA0, pA1, alA, l_reg, pa0, pa1, pa2, pa3); ATT_SBAR();
    ATT_SLOAD(SO, (j + SDEPTH) * KVBLK); ATT_SBAR();
    pv_all<DV>(o, vb0, pa0, pa1, pa2, pa3); partialSM<MASK>(pB0, pB1, m_reg, mnB, alB, dq0 + j * KVBLK, hi, win);
    __syncthreads(); ATT_SWAIT(); ATT_SWRITE(0, SE);
    ATT_RESC(alB); __syncthreads();
    ATT_SBAR(); qkt(pA0, pA1, K_lds, qr, r32, hi);
    finishSM(pB0, pB1, alB, l_reg, pa0, pa1, pa2, pa3); ATT_SBAR();
    if (SDEPTH == 1 || j + 3 < NT) ATT_SLOAD(SE, (j + 1 + SDEPTH) * KVBLK); ATT_SBAR();
    pv_all<DV>(o, vb0 + SHM_V, pa0, pa1, pa2, pa3); partialSM<MASK>(pA0, pA1, m_reg, mnA, alA, dq0 + (j + 1) * KVBLK, hi, win);
    __syncthreads(); ATT_SWAIT(); ATT_SWRITE(1, SO);
    ATT_RESC(alA); __syncthreads();
  }
  ATT_SBAR(); qkt(pB0, pB1, K_lds + SHM_K, qr, r32, hi);
  finishSM(pA0, pA1, alA, l_reg, pa0, pa1, pa2, pa3); ATT_SBAR();
  pv_all<DV>(o, vb0, pa0, pa1, pa2, pa3); partialSM<MASK>(pB0, pB1, m_reg, mnB, alB, dq0 + (NT - 1) * KVBLK, hi, win);
  ATT_RESC(alB);
  finishSM(pB0, pB1, alB, l_reg, pa0, pa1, pa2, pa3); ATT_SBAR();
  pv_all<DV>(o, vb0 + SHM_V, pa0, pa1, pa2, pa3);
  l_out = l_reg;
#undef ATT_SLOAD
#undef ATT_SWRITE
#undef ATT_SWAIT
#undef ATT_RESC
}
}

constexpr int NWAVES = 8;
constexpr int SEQ = 16384, DM = 1024, DEPTH = 2, DIN = 3840, NGATE = 3072, DFF = 2816, NUP = 2 * DFF;
constexpr float LN_EPS = 1e-5f;
constexpr float ALPHA = 1.4142135623730951f;
constexpr int NPHASE = 1 + 9 * DEPTH;

constexpr size_t MiB = 1u << 20;
constexpr size_t WS_CTL = 0, CTL_ZERO_BYTES = 1 * MiB;
constexpr size_t WS_COS = 1 * MiB, WS_SIN = 3 * MiB;
constexpr size_t WS_W = 5 * MiB, W_LAYER = 35 * MiB;
constexpr size_t WO_IN = 0, WO_G = 7864320, WO_BR = WO_G + 6 * MiB, WO_O = WO_BR + 3 * MiB, WO_UP = WO_O + 2 * MiB, WO_DN = WO_UP + 11 * MiB;
static_assert(WO_DN + (size_t)DM * DFF * 2 <= W_LAYER, "weight map");
constexpr size_t WS_HA = 75 * MiB;
constexpr size_t WS_YS = 107 * MiB;
constexpr size_t WS_HP = 107 * MiB;
constexpr int HP_ROWS = 1 + SEQ + 127;
constexpr size_t WS_R1 = 155 * MiB;
constexpr size_t WS_U = WS_R1, WS_DK = WS_R1 + 16 * MiB, WS_DV = WS_R1 + 32 * MiB, WS_SK = WS_R1 + 48 * MiB, WS_SV = WS_R1 + 52 * MiB;
constexpr size_t WS_GT = WS_R1;
constexpr size_t WS_ACT = WS_R1;
constexpr size_t WS_SCR = 211 * MiB;
constexpr size_t WS_END = 251 * MiB;
static_assert(WS_HP + (size_t)HP_ROWS * DM * 2 <= WS_R1 && WS_GT + (size_t)SEQ * NGATE * 2 <= WS_END && WS_SCR + 32 * MiB <= WS_END && WS_SV + 4 * MiB <= WS_SCR, "d_ws map");

constexpr int CW_BAR = 4096;
constexpr int RING_OFF = 0, RING_BYTES = 131072, XLDS_OFF = RING_BYTES, XLDS_BYTES = 8192, LDSCTL_OFF = XLDS_OFF + XLDS_BYTES, MISC_OFF = LDSCTL_OFF + 320;
constexpr int LDS_BYTES = 147456;
static_assert(MISC_OFF + 128 <= LDS_BYTES, "LDS map");

#define GAS __attribute__((address_space(1)))
#define LAS __attribute__((address_space(3)))
typedef unsigned short bf16;
typedef unsigned v4u __attribute__((ext_vector_type(4)));
typedef unsigned v2u __attribute__((ext_vector_type(2)));
typedef float f32x4 __attribute__((ext_vector_type(4)));
#define RLX_AGENT __ATOMIC_RELAXED, __HIP_MEMORY_SCOPE_AGENT
#define LDS_WAIT() asm volatile("s_waitcnt lgkmcnt(0)" ::: "memory")
#define VM_WAIT() asm volatile("s_waitcnt vmcnt(0)" ::: "memory")
__device__ __forceinline__ unsigned f2bf(float f) { unsigned u = __builtin_bit_cast(unsigned, f); return (u + 0x7fffu + ((u >> 16) & 1u)) >> 16; }
__device__ __forceinline__ unsigned pk2(float lo, float hi) { return f2bf(lo) | (f2bf(hi) << 16); }

#define XB_TMO      128
#define XB_XCNT(j)  (256  + 64 * (j))
#define XB_XSUB(j)  (1280 + 64 * (j))
#define XB_XGEN(j)  (2304 + 64 * (j))
#define XB_TOP      3328
#define XB_TOPGEN   3392
#define XCD_BAR_WORDS 3456
#define XB_SPIN_CAP (1u << 22)
__device__ __forceinline__ unsigned xb_ld(unsigned* p)              { return __hip_atomic_load(p, __ATOMIC_RELAXED, __HIP_MEMORY_SCOPE_AGENT); }
__device__ __forceinline__ unsigned xb_add(unsigned* p, unsigned v) { return __hip_atomic_fetch_add(p, v, __ATOMIC_RELAXED, __HIP_MEMORY_SCOPE_AGENT); }
__device__ __forceinline__ unsigned xb_xcc_id() { return (unsigned)__builtin_amdgcn_s_getreg((3 << 11) | 20) & 0xFu; }
#define XB_SPIN(cond, bar) do { unsigned _sp = 0; while (cond) { __builtin_amdgcn_s_sleep(1); \
    if ((++_sp & 255u) == 0u) { if (xb_ld(&(bar)[XB_TMO])) break; if (_sp > XB_SPIN_CAP) { atomicAdd(&(bar)[XB_TMO], 1u); break; } } } } while (0)
struct XcdBarrier { unsigned* bar; unsigned x; volatile LAS unsigned* st; };
__device__ __forceinline__ XcdBarrier xcd_barrier_post(unsigned* bar, volatile LAS unsigned* st) {
    XcdBarrier b; b.bar = bar; b.x = xb_xcc_id(); b.st = st;
    if (threadIdx.x == 0) (void)xb_add(&bar[XB_XCNT(b.x)], 1u);
    return b;
}
__device__ __forceinline__ void xcd_barrier_complete(unsigned* bar, unsigned x, unsigned& nloc, unsigned& nx) {
    const unsigned G = gridDim.x * gridDim.y * gridDim.z;
    unsigned sum, cnt, mine, sp = 0u;
    for (;;) {
        sum = 0u; cnt = 0u; mine = 0u;
#pragma unroll
        for (unsigned j = 0; j < 16; ++j) { const unsigned c = xb_ld(&bar[XB_XCNT(j)]); sum += c; cnt += (c > 0u) ? 1u : 0u; mine = (j == x) ? c : mine; }
        if (sum == G) break;
        __builtin_amdgcn_s_sleep(1);
        if ((++sp & 255u) == 0u) { if (xb_ld(&bar[XB_TMO])) break; if (sp > XB_SPIN_CAP) { atomicAdd(&bar[XB_TMO], 1u); break; } }
    }
    nloc = mine > 0u ? mine : 1u; nx = cnt > 0u ? cnt : 1u;
}
__device__ __forceinline__ void xcd_barrier(const XcdBarrier& b) {
    asm volatile("s_waitcnt vmcnt(0)" ::: "memory");
    __syncthreads();
    if (threadIdx.x == 0) {
        unsigned* bar = b.bar;
        __builtin_amdgcn_s_waitcnt(0);
        unsigned nloc = b.st[0], nx = b.st[1];
        if (nloc == 0u) { xcd_barrier_complete(bar, b.x, nloc, nx); b.st[0] = nloc; b.st[1] = nx; }
        const unsigned old = xb_add(&bar[XB_XSUB(b.x)], 1u);
        const unsigned gen = old / nloc;
        if (old + 1u == (gen + 1u) * nloc) {
            __builtin_amdgcn_fence(__ATOMIC_RELEASE, "agent");
            asm volatile("s_waitcnt vmcnt(0)" ::: "memory");
            const unsigned og = xb_add(&bar[XB_TOP], 1u);
            const unsigned tg = og / nx;
            if (og + 1u == (tg + 1u) * nx) xb_add(&bar[XB_TOPGEN], 1u);
            else XB_SPIN(xb_ld(&bar[XB_TOPGEN]) == tg, bar);
            __builtin_amdgcn_fence(__ATOMIC_ACQUIRE, "agent");
            xb_add(&bar[XB_XGEN(b.x)], 1u);
            asm volatile("s_waitcnt vmcnt(0)" ::: "memory");
        } else {
            XB_SPIN(xb_ld(&bar[XB_XGEN(b.x)]) == gen, bar);
            __builtin_amdgcn_fence(__ATOMIC_ACQUIRE, "agent");
            asm volatile("s_waitcnt vmcnt(0)" ::: "memory");
        }
    }
    __syncthreads();
}

__device__ __forceinline__ float wave_sum(float v) {
#pragma unroll
    for (int o = 1; o < 64; o <<= 1) v += __shfl_xor(v, o);
    return v;
}
__device__ __forceinline__ void conv_item(const float* W, int ldw, int k0, int srcc, bf16* WT, int ldt, int dstr, int dstk, LAS float* scr, int lane) {
#pragma unroll 8
    for (int i = 0; i < 32; ++i) { const int kk = 2 * i + (lane >> 5); scr[kk * 33 + (lane & 31)] = W[(size_t)(k0 + kk) * ldw + srcc + (lane & 31)]; }
    LDS_WAIT(); asm volatile("" ::: "memory");
    const int c = lane & 7;
#pragma unroll
    for (int j = 0; j < 4; ++j) { const int n = (lane >> 3) + 8 * j; const LAS float* s = scr + (8 * c) * 33 + n;
        v4u o; o.x = pk2(s[0 * 33], s[1 * 33]); o.y = pk2(s[2 * 33], s[3 * 33]); o.z = pk2(s[4 * 33], s[5 * 33]); o.w = pk2(s[6 * 33], s[7 * 33]);
        *(GAS v4u*)(WT + (size_t)(dstr + n) * ldt + dstk + 8 * c) = o; }
    LDS_WAIT(); asm volatile("" ::: "memory");
}
__device__ __forceinline__ int inmap(int gd) {
    const int tile = gd >> 3, bj = (gd >> 2) & 1, wc = gd & 3;
    if (tile < 4)  return (bj ? 1024 : 0) + 128 * tile + 32 * wc;
    if (tile < 6)  return 512 + 32 * (gd - 32);
    if (tile < 8)  return 1536 + (4 * (tile - 6) + wc) * 64 + 32 * bj;
    if (tile < 10) return 2048 + (4 * (tile - 8) + wc) * 64 + 32 * bj;
    if (tile < 12) return 2560 + 32 * (gd - 80);
    if (tile < 14) return 3072 + (4 * (tile - 12) + wc) * 64 + 32 * bj;
    return (wc < 2) ? 3584 + wc * 64 + 32 * bj : 3712 + 64 * bj + 32 * (wc - 2);
}
__device__ __forceinline__ int upmap(int gd) { const int tile = gd >> 3, bj = (gd >> 2) & 1, wc = gd & 3; return (bj ? DFF : 0) + 128 * tile + 32 * wc; }

__device__ __forceinline__ void ln_row(const float* src, const float* g, const float* b, float* dst32, bf16* dst16, int lane) {
    const f32x4* xr = (const f32x4*)src + lane;
    f32x4 v[4]; float s = 0.f;
#pragma unroll
    for (int j = 0; j < 4; ++j) { v[j] = xr[64 * j]; s += (v[j].x + v[j].y) + (v[j].z + v[j].w); }
    const float mean = wave_sum(s) * (1.f / DM); float s2 = 0.f;
#pragma unroll
    for (int j = 0; j < 4; ++j) { v[j] = v[j] - mean; s2 += (v[j].x * v[j].x + v[j].y * v[j].y) + (v[j].z * v[j].z + v[j].w * v[j].w); }
    const float rstd = 1.f / sqrtf(wave_sum(s2) * (1.f / DM) + LN_EPS);
#pragma unroll
    for (int j = 0; j < 4; ++j) { const f32x4 gg = ((const f32x4*)g)[lane + 64 * j], bb = ((const f32x4*)b)[lane + 64 * j];
        const f32x4 y = v[j] * rstd * gg + bb;
        ((f32x4*)dst32)[lane + 64 * j] = y;
        v2u w; w.x = pk2(y.x, y.y); w.y = pk2(y.z, y.w); ((v2u*)dst16)[lane + 64 * j] = w; }
}
__device__ __forceinline__ void sincos_d(double a, double& sn, double& cs) {
    const double q = __builtin_rint(a * 0.63661977236758134308);
    double r = __builtin_fma(-q, 1.57079632679489655800e+00, a); r = __builtin_fma(-q, 6.12323399573676603587e-17, r);
    const double r2 = r * r;
    double s = -7.6471637318198164759e-13; s = s * r2 + 1.6059043836821614599e-10; s = s * r2 - 2.5052108385441718775e-08; s = s * r2 + 2.7557319223985890653e-06;
    s = s * r2 - 1.9841269841269841270e-04; s = s * r2 + 8.3333333333333333333e-03; s = s * r2 - 1.6666666666666666667e-01; s = r + r * r2 * s;
    double c = 4.7794773323873852974e-14; c = c * r2 - 1.1470745597729724714e-11; c = c * r2 + 2.0876756987868098979e-09; c = c * r2 - 2.7557319223985890653e-07;
    c = c * r2 + 2.4801587301587301587e-05; c = c * r2 - 1.3888888888888888889e-03; c = c * r2 + 4.1666666666666666667e-02; c = c * r2 - 0.5; c = c * r2 + 1.0;
    const int qi = (int)((long long)q & 3);
    sn = (qi == 0) ? s : (qi == 1) ? c : (qi == 2) ? -s : -c;
    cs = (qi == 0) ? c : (qi == 1) ? -s : (qi == 2) ? -c : s;
}
__device__ __forceinline__ float rope_theta_pow(int i) {
    constexpr double T[32] = {1, 1.333521432163324, 1.7782794100389228, 2.3713737056616551, 3.1622776601683795, 4.2169650342858223, 5.6234132519034912, 7.4989420933245583, 10, 13.33521432163324,
        17.782794100389228, 23.713737056616552, 31.622776601683793, 42.169650342858226, 56.234132519034908, 74.989420933245583, 100, 133.35214321633239, 177.82794100389228, 237.13737056616552,
        316.22776601683796, 421.69650342858228, 562.34132519034904, 749.89420933245583, 1000, 1333.5214321633241, 1778.2794100389228, 2371.3737056616551, 3162.2776601683795, 4216.9650342858222,
        5623.4132519034911, 7498.9420933245583};
    return (float)T[i];
}

#ifndef MK_DIAG
#define MK_DIAG -1
#endif
#define PH_EN(k) ((MK_DIAG) < 0 || (MK_DIAG) == (k))
#ifndef ATT_SD
#define ATT_SD 1
#endif
struct Params { const float* in[20]; float* out; unsigned char* ws; int ph_lo, ph_hi, li, pad; };
enum { I_X = 0, I_POS, I_LNG, I_LNB, I_WIN, I_CONVW, I_DLAM, I_SUBG, I_SINK, I_WGATE, I_BGATE, I_WBR, I_WO, I_LMG, I_LMB, I_WUP, I_FCW, I_WDN, I_LFG, I_LFB };

template <int SUB>
__device__ __forceinline__ void run_phase(const int l, const int wave_s, LAS unsigned char* L, unsigned char* lds) {
        int lane_; asm volatile("v_mbcnt_lo_u32_b32 %0, -1, 0\n\tv_mbcnt_hi_u32_b32 %0, -1, %0" : "=v"(lane_));
        int bx = blockIdx.x, G = gridDim.x, wave = wave_s;
        asm volatile("" : "+s"(bx)); asm volatile("" : "+s"(G)); asm volatile("" : "+s"(wave));
        const int lane = lane_, tid = wave * 64 + lane_;
        const int vcu = (G % 8 == 0) ? (bx % 8) * (G / 8) + bx / 8 : bx;
        const int gw = vcu * NWAVES + wave, NGW = G * NWAVES;
        const __attribute__((address_space(4))) Params* pp = (const __attribute__((address_space(4))) Params*)__builtin_amdgcn_kernarg_segment_ptr();
        asm volatile("" : "+s"(pp));
#define PIN(i) (pp->in[i])
        unsigned char* ws = pp->ws;
        float* H32 = pp->out;
        float* COS = (float*)(ws + WS_COS); float* SIN = (float*)(ws + WS_SIN);
        bf16* HA = (bf16*)(ws + WS_HA); bf16* YS = (bf16*)(ws + WS_YS); bf16* HP = (bf16*)(ws + WS_HP);
        bf16* UB = (bf16*)(ws + WS_U); bf16* DKB = (bf16*)(ws + WS_DK); bf16* DVB = (bf16*)(ws + WS_DV); bf16* SKB = (bf16*)(ws + WS_SK); bf16* SVB = (bf16*)(ws + WS_SV);
        bf16* GT = (bf16*)(ws + WS_GT); bf16* ACT = (bf16*)(ws + WS_ACT); float* SCR = (float*)(ws + WS_SCR);
        unsigned char* wl = ws + WS_W + (size_t)l * W_LAYER;
        (void)lane; (void)gw; (void)NGW; (void)H32; (void)COS; (void)SIN; (void)HA; (void)YS; (void)HP; (void)UB; (void)DKB; (void)DVB; (void)SKB; (void)SVB; (void)GT; (void)ACT; (void)SCR; (void)wl; (void)vcu;
        if constexpr (SUB == -1) {
            LAS float* scr = (LAS float*)(L + RING_OFF + wave * 16384);
            constexpr int N_IN = 16 * 120, N_G = 16 * 96, N_BR = 3 * 8 * 32, N_O = 16 * 32, N_UP = 16 * 176, N_DN = 44 * 32, N_L = N_IN + N_G + N_BR + N_O + N_UP + N_DN;
            for (int it = gw; it < DEPTH * N_L; it += NGW) {
                const int ll = it / N_L; int r = it - ll * N_L; unsigned char* wb = ws + WS_W + (size_t)ll * W_LAYER;
                if (r < N_IN) { const int kb = r / 120, gd = r % 120; conv_item(PIN(I_WIN) + (size_t)ll * DM * DIN, DIN, kb * 64, inmap(gd), (bf16*)(wb + WO_IN), DM, gd * 32, kb * 64, scr, lane); continue; } r -= N_IN;
                if (r < N_G) { const int kb = r / 96, gd = r % 96; conv_item(PIN(I_WGATE) + (size_t)ll * DM * NGATE, NGATE, kb * 64, gd * 32, (bf16*)(wb + WO_G), DM, gd * 32, kb * 64, scr, lane); continue; } r -= N_G;
                if (r < N_BR) { const int n = r / 256, rr = r % 256, kb = rr / 32, gd = rr % 32; conv_item(PIN(I_WBR) + (size_t)(ll * 3 + n) * 512 * DM, DM, kb * 64, gd * 32, (bf16*)(wb + WO_BR), 1536, gd * 32, n * 512 + kb * 64, scr, lane); continue; } r -= N_BR;
                if (r < N_O) { const int kb = r / 32, gd = r % 32; conv_item(PIN(I_WO) + (size_t)ll * DM * DM, DM, kb * 64, gd * 32, (bf16*)(wb + WO_O), DM, gd * 32, kb * 64, scr, lane); continue; } r -= N_O;
                if (r < N_UP) { const int kb = r / 176, gd = r % 176; conv_item(PIN(I_WUP) + (size_t)ll * DM * NUP, NUP, kb * 64, upmap(gd), (bf16*)(wb + WO_UP), DM, gd * 32, kb * 64, scr, lane); continue; } r -= N_UP;
                { const int kb = r / 32, gd = r % 32; conv_item(PIN(I_WDN) + (size_t)ll * DFF * DM, DM, kb * 64, gd * 32, (bf16*)(wb + WO_DN), DFF, gd * 32, kb * 64, scr, lane); }
            }
            const int* pos = (const int*)PIN(I_POS);
            for (int idx = vcu * 512 + tid; idx < SEQ * 32; idx += G * 512) {
                const int t = idx >> 5, i = idx & 31;
                const float inv = 1.0f / rope_theta_pow(i);
                const float ang = (float)pos[t] * inv;
                double sd, cd; sincos_d((double)ang, sd, cd);
                COS[idx] = (float)cd; SIN[idx] = (float)sd;
            }
            for (int m = gw; m < SEQ; m += NGW) ln_row(PIN(I_X) + (size_t)m * DM, PIN(I_LNG), PIN(I_LNB), H32 + (size_t)m * DM, HA + (size_t)m * DM, lane);
        } else if constexpr (SUB == 0) {
            pg8::Gemm g{HA, (const bf16*)(wl + WO_IN), DM, DM, DM}; pg8::StaticOrder S; S.init(SEQ / 256, DIN / 256, G, bx, 256);
            pg8::EpiInProj E{UB, YS, DKB, DVB, SKB, SVB, COS, SIN};
            pg8::gemm_phase<pg8::EpiInProj, pg8::StaticOrder, true>(tid, L + RING_OFF, L + XLDS_OFF, g, S, E);
        } else if constexpr (SUB == 1) {
            char* al = (char*)lds;
            const int r32 = lane & 31, hi = lane >> 5;
            const float lambda_init = (l == 0) ? 0.2f : 0.35550906759096934f;
#ifndef MK_NO_DIFF
            for (int pair = vcu; pair < 256; pair += G) {
                const int h = pair >> 6, qb = pair & 63;
                const size_t qrow = (size_t)qb * 256 + wave * 32 + r32;
                f32x4* scr = (f32x4*)(SCR + ((size_t)(pair * 8 + wave) * 64 + lane) * 64);
                att::f32x16 o[4]; float lsum;
                att::attn_core<128, false, ATT_SD, 512, 512>(tid, YS + qrow * 1536 + 512 + h * 128 + hi * 8, DKB + h * 128, DVB + h * 128, SEQ / 64, -1e30f, 0.f, 0, 0, al, o, lsum);
                { const float rl = 1.0f / lsum;
#pragma unroll
                  for (int d = 0; d < 4; ++d)
#pragma unroll
                      for (int g4 = 0; g4 < 4; ++g4) scr[d * 4 + g4] = (f32x4){o[d][4 * g4] * rl, o[d][4 * g4 + 1] * rl, o[d][4 * g4 + 2] * rl, o[d][4 * g4 + 3] * rl}; }
                __syncthreads();
                att::attn_core<128, false, ATT_SD, 512, 512>(tid, YS + qrow * 1536 + 512 + h * 128 + 64 + hi * 8, DKB + h * 128 + 64, DVB + h * 128, SEQ / 64, -1e30f, 0.f, 0, 0, al, o, lsum);
                const float* lp = PIN(I_DLAM) + l * 256;
                const float s01 = wave_sum(lp[lane] * lp[64 + lane]), s23 = wave_sum(lp[128 + lane] * lp[192 + lane]);
                const float lam = __builtin_amdgcn_exp2f(s01 * 1.4426950408889634f) - __builtin_amdgcn_exp2f(s23 * 1.4426950408889634f) + lambda_init;
                const float rl1 = lam / lsum; float ss = 0.f;
                VM_WAIT();
#pragma unroll
                for (int d = 0; d < 4; ++d)
#pragma unroll
                    for (int g4 = 0; g4 < 4; ++g4) { const f32x4 sv = scr[d * 4 + g4];
#pragma unroll
                        for (int e = 0; e < 4; ++e) { const float y = sv[e] - o[d][4 * g4 + e] * rl1; o[d][4 * g4 + e] = y; ss += y * y; } }
                { auto rr = __builtin_amdgcn_permlane32_swap(__float_as_uint(ss), __float_as_uint(ss), false, false); ss = __uint_as_float(rr[0]) + __uint_as_float(rr[1]); }
                const float rms = (1.0f - lambda_init) / sqrtf(ss * (1.0f / 128.0f) + LN_EPS);
                const float* sg = PIN(I_SUBG) + l * 128;
                bf16* op = YS + qrow * 1536 + 512 + h * 128;
#pragma unroll
                for (int d = 0; d < 4; ++d)
#pragma unroll
                    for (int g4 = 0; g4 < 4; ++g4) { const int dc = 32 * d + 8 * g4 + 4 * hi; const f32x4 gg = *(const f32x4*)(sg + dc);
                        v2u w; w.x = pk2(o[d][4 * g4] * rms * gg.x, o[d][4 * g4 + 1] * rms * gg.y); w.y = pk2(o[d][4 * g4 + 2] * rms * gg.z, o[d][4 * g4 + 3] * rms * gg.w);
                        *(v2u*)(op + dc) = w; }
                __syncthreads();
            }
#endif
#ifndef MK_NO_SWA
            for (int su = vcu; su < 512; su += G) {
                const int hq = su >> 6, qb = su & 63, q0 = qb * 256, kvh = hq >> 2;
                const int ks = (q0 - 128 < 0) ? 0 : q0 - 128, ke = (q0 + 384 > SEQ) ? SEQ : q0 + 384, NT = (ke - ks) / 64;
                const int qpos = q0 + wave * 32 + r32;
                att::f32x16 o[2]; float lsum;
                att::attn_core<64, true, 2, 128, 128>(tid, YS + (size_t)qpos * 1536 + 1024 + hq * 64 + hi * 8, SKB + (size_t)ks * 128 + kvh * 64, SVB + (size_t)ks * 128 + kvh * 64, NT,
                                         PIN(I_SINK)[l * 8 + hq] * 8.0f, 1.0f, ks - qpos, 128, al, o, lsum);
                const float rl = 1.0f / lsum;
                bf16* op = YS + (size_t)qpos * 1536 + 1024 + hq * 64;
#pragma unroll
                for (int d = 0; d < 2; ++d)
#pragma unroll
                    for (int g4 = 0; g4 < 4; ++g4) { const int dc = 32 * d + 8 * g4 + 4 * hi;
                        v2u w; w.x = pk2(o[d][4 * g4] * rl, o[d][4 * g4 + 1] * rl); w.y = pk2(o[d][4 * g4 + 2] * rl, o[d][4 * g4 + 3] * rl);
                        *(v2u*)(op + dc) = w; }
                __syncthreads();
            }
#endif
            const float* cw = PIN(I_CONVW) + l * 3 * 512;
            for (int idx = vcu * 512 + tid; idx < SEQ * 64; idx += G * 512) {
                const int t = idx >> 6, c8 = (idx & 63) * 8;
                const v4u z = {0u, 0u, 0u, 0u};
                const v4u uc = *(const v4u*)(UB + (size_t)t * 512 + c8);
                const v4u up = (t > 0) ? *(const v4u*)(UB + (size_t)(t - 1) * 512 + c8) : z;
                const v4u un = (t < SEQ - 1) ? *(const v4u*)(UB + (size_t)(t + 1) * 512 + c8) : z;
                const v4u ab = *(const v4u*)(YS + (size_t)t * 1536 + c8);
                f32x4 ca, cb, pa, pb, na, nb, ba, bb; pg8::unpack8(uc, ca, cb); pg8::unpack8(up, pa, pb); pg8::unpack8(un, na, nb); pg8::unpack8(ab, ba, bb);
                const f32x4 w0a = *(const f32x4*)(cw + c8), w0b = *(const f32x4*)(cw + c8 + 4), w1a = *(const f32x4*)(cw + 512 + c8), w1b = *(const f32x4*)(cw + 512 + c8 + 4);
                const f32x4 w2a = *(const f32x4*)(cw + 1024 + c8), w2b = *(const f32x4*)(cw + 1024 + c8 + 4);
                const f32x4 ya = ba * (w0a * pa + w1a * ca + w2a * na), yb = bb * (w0b * pb + w1b * cb + w2b * nb);
                *(v4u*)(YS + (size_t)t * 1536 + c8) = pg8::pack8(ya, yb);
            }
        } else if constexpr (SUB == 2) {
            pg8::Gemm g{HA, (const bf16*)(wl + WO_G), DM, DM, DM}; pg8::StaticOrder S; S.init(SEQ / 256, NGATE / 256, G, bx, 256);
            pg8::EpiGates E{GT, PIN(I_BGATE) + l * NGATE};
            pg8::gemm_phase<pg8::EpiGates, pg8::StaticOrder, true>(tid, L + RING_OFF, L + XLDS_OFF, g, S, E);
        } else if constexpr (SUB == 3) {
            pg8::Gemm g{YS, (const bf16*)(wl + WO_BR), 1536, 1536, 512}; pg8::SegOrder S; S.init(SEQ / 256, DM / 256, G, bx, 3, 512);
            pg8::EpiBranch E{HA, GT};
            pg8::gemm_phase<pg8::EpiBranch, pg8::SegOrder, true>(tid, L + RING_OFF, L + XLDS_OFF, g, S, E);
        } else if constexpr (SUB == 4 || SUB == 7) {
            pg8::Gemm g{(SUB == 4) ? HA : ACT, (const bf16*)(wl + ((SUB == 4) ? WO_O : WO_DN)), (SUB == 4) ? DM : DFF, (SUB == 4) ? DM : DFF, (SUB == 4) ? DM : DFF};
            pg8::StaticOrder S; S.init(SEQ / 256, DM / 256, G, bx, 256);
            pg8::EpiResid E{H32, ALPHA};
            pg8::gemm_phase<pg8::EpiResid, pg8::StaticOrder, true>(tid, L + RING_OFF, L + XLDS_OFF, g, S, E);
        } else if constexpr (SUB == 5 || SUB == 8) {
            const float* gg = PIN((SUB == 5) ? I_LMG : I_LFG) + l * DM; const float* bb = PIN((SUB == 5) ? I_LMB : I_LFB) + l * DM;
            bf16* dst = (SUB == 5) ? HP + DM : HA;
            for (int m = gw; m < SEQ; m += NGW) ln_row(H32 + (size_t)m * DM, gg, bb, H32 + (size_t)m * DM, dst + (size_t)m * DM, lane);
            if (SUB == 5) {
                for (int idx = vcu * 512 + tid; idx < 128 * (DM / 8); idx += G * 512) { const int rr = idx / (DM / 8), c8 = (idx % (DM / 8)) * 8; const int row = (rr == 0) ? 0 : SEQ + rr;
                    *(v4u*)(HP + (size_t)row * DM + c8) = (v4u){0u, 0u, 0u, 0u}; }
            }
        } else if constexpr (SUB == 9) {
#ifdef MK_DUMP
            for (int idx = vcu * 512 + tid; idx < SEQ * 128; idx += G * 512) {
                const int t = idx >> 7, c8 = (idx & 127) * 8;
                const bf16* src;
                if (MK_DUMP == 1) src = YS + (size_t)t * 1536 + c8;
                else if (MK_DUMP == 2) src = YS + (size_t)t * 1536 + 512 + c8;
                else if (MK_DUMP == 3) src = UB + (size_t)t * 512 + (c8 & 511);
                else if (MK_DUMP == 4) src = (c8 < 512) ? DKB + (size_t)t * 512 + c8 : DVB + (size_t)t * 512 + (c8 - 512);
                else if (MK_DUMP == 5) src = (c8 < 512) ? SKB + (size_t)t * 128 + (c8 & 127) : SVB + (size_t)t * 128 + (c8 & 127);
                else if (MK_DUMP == 6) src = GT + (size_t)t * 3072 + c8;
                else if (MK_DUMP == 7) src = GT + (size_t)t * 3072 + 1024 + c8;
                else if (MK_DUMP == 8) src = GT + (size_t)t * 3072 + 2048 + c8;
                else src = HA + (size_t)t * 1024 + c8;
                const v4u w = *(const v4u*)src; f32x4 a, b; pg8::unpack8(w, a, b);
                *(f32x4*)(H32 + (size_t)t * 1024 + c8) = a; *(f32x4*)(H32 + (size_t)t * 1024 + c8 + 4) = b;
            }
#endif
        } else if constexpr (SUB == 6) {
            pg8::Gemm g{HP, (const bf16*)(wl + WO_UP), DM, DM, DM}; pg8::StaticOrder S; S.init(65, NUP / 256, G, bx, 254);
            pg8::EpiUpConv E{ACT, PIN(I_FCW) + (size_t)l * 3 * NUP};
            pg8::gemm_phase<pg8::EpiUpConv, pg8::StaticOrder, true>(tid, L + RING_OFF, L + XLDS_OFF, g, S, E);
        }
#undef PIN
}

__global__ void __launch_bounds__(NWAVES * 64, 2) mk_fwd(Params p) {
    extern __shared__ __attribute__((aligned(16))) unsigned char lds[];
    LAS unsigned char* L = (LAS unsigned char*)lds;
    volatile LAS unsigned* MISC = (volatile LAS unsigned*)(L + MISC_OFF);
    for (int u = threadIdx.x; u < (LDS_BYTES - LDSCTL_OFF) / 4; u += NWAVES * 64) ((LAS unsigned*)(L + LDSCTL_OFF))[u] = 0u;
    __syncthreads();
    const int wave_s = __builtin_amdgcn_readfirstlane((int)threadIdx.x >> 6);
#if MK_ONE_LAUNCH
    (void)xcd_barrier_post((unsigned*)(p.ws + WS_CTL) + CW_BAR, MISC + 8);
#define GRID_BAR() do { XcdBarrier bar_; bar_.bar = (unsigned*)(((const __attribute__((address_space(4))) Params*)__builtin_amdgcn_kernarg_segment_ptr())->ws + WS_CTL) + CW_BAR; bar_.x = xb_xcc_id(); bar_.st = MISC + 8; xcd_barrier(bar_); } while (0)
    constexpr int lo = 0, hi = NPHASE;
#else
    (void)MISC;
#define GRID_BAR() do {} while (0)
    const int lo = p.ph_lo, hi = p.ph_hi;
#endif
#define PH(k, SUBV, lv) if (PH_EN(k) && lo <= (k) && (k) < hi) { run_phase<SUBV>(lv, wave_s, L, lds); if ((k) + 1 < hi) GRID_BAR(); }
    PH(0, -1, 0)
    PH(1, 0, 0) PH(2, 1, 0) PH(3, 2, 0) PH(4, 3, 0) PH(5, 4, 0) PH(6, 5, 0) PH(7, 6, 0) PH(8, 7, 0) PH(9, 8, 0)
    PH(10, 0, 1) PH(11, 1, 1) PH(12, 2, 1) PH(13, 3, 1) PH(14, 4, 1) PH(15, 5, 1) PH(16, 6, 1) PH(17, 7, 1) PH(18, 8, 1)
#ifdef MK_DUMP
    PH(19, 9, 0)
#endif
#undef PH
}

extern "C" void kernel_launch(void* const* d_in, const int* in_sizes, int n_in, void* d_out, int out_size, void* d_ws, size_t ws_size, hipStream_t stream) {
    static int grid = 0;
    if (grid == 0) {
        if (n_in != 20 || in_sizes[0] != SEQ * DM || out_size != SEQ * DM || ws_size < WS_END) { fprintf(stderr, "kernel_launch: shape/workspace mismatch n_in %d in0 %d out %d ws %zu (need %zu)\n", n_in, n_in > 0 ? in_sizes[0] : -1, out_size, ws_size, (size_t)WS_END); grid = -1; return; }
        int dev = 0, cus = 0, per_cu = 0;
        if (hipGetDevice(&dev) != hipSuccess || hipDeviceGetAttribute(&cus, hipDeviceAttributeMultiprocessorCount, dev) != hipSuccess) { grid = -1; return; }
        if (hipFuncSetAttribute((const void*)mk_fwd, hipFuncAttributeMaxDynamicSharedMemorySize, LDS_BYTES) != hipSuccess) { fprintf(stderr, "kernel_launch: hipFuncSetAttribute failed\n"); grid = -1; return; }
        if (hipOccupancyMaxActiveBlocksPerMultiprocessor(&per_cu, (const void*)mk_fwd, NWAVES * 64, LDS_BYTES) != hipSuccess || per_cu < 1) { fprintf(stderr, "kernel_launch: occupancy query says %d blocks per CU\n", per_cu); (void)hipGetLastError(); grid = -1; return; }
        grid = cus;
    }
    if (grid < 0) return;
    if (hipMemsetAsync((char*)d_ws + WS_CTL, 0, CTL_ZERO_BYTES, stream) != hipSuccess) return;
    Params a{};
    for (int i = 0; i < 20; ++i) a.in[i] = (const float*)d_in[i];
    a.out = (float*)d_out; a.ws = (unsigned char*)d_ws; a.li = 0; a.pad = 0;
#if MK_ONE_LAUNCH
    a.ph_lo = 0; a.ph_hi = NPHASE;
    hipLaunchKernelGGL(mk_fwd, dim3(grid), dim3(NWAVES * 64), LDS_BYTES, stream, a);
#else
#ifdef MK_PHLIST
    { const int phl[] = MK_PHLIST; for (int i = 0; i < (int)(sizeof(phl) / sizeof(int)); ++i) { a.ph_lo = phl[i]; a.ph_hi = phl[i] + 1; hipLaunchKernelGGL(mk_fwd, dim3(grid), dim3(NWAVES * 64), LDS_BYTES, stream, a); } }
#else
    for (int ph = 0; ph < NPHASE; ++ph) { a.ph_lo = ph; a.ph_hi = ph + 1; hipLaunchKernelGGL(mk_fwd, dim3(grid), dim3(NWAVES * 64), LDS_BYTES, stream, a); }
#endif
#endif
    const hipError_t le = hipPeekAtLastError();
    if (le != hipSuccess) fprintf(stderr, "kernel_launch: launch failed: %s\n", hipGetErrorName(le));
}
```

```cpp
#include <hip/hip_runtime.h>
#include <hip/hip_bf16.h>
#include <cstdio>
#include <cstdint>

#ifndef MK_ONE_LAUNCH
#define MK_ONE_LAUNCH 1
#endif

namespace pg8 {
#define PG8_LAS __attribute__((address_space(3)))
typedef unsigned short bf16_t;
typedef short bf16x8 __attribute__((ext_vector_type(8)));
typedef float f32x4 __attribute__((ext_vector_type(4)));
typedef float f32x2 __attribute__((ext_vector_type(2)));
typedef unsigned u32x4 __attribute__((ext_vector_type(4)));
typedef unsigned u32x2 __attribute__((ext_vector_type(2)));
constexpr int BM = 256, BK = 64, HALF = 128, HTB = HALF * BK * 2  , STAGE_BYTES = 8 * HTB, NXCD = 8, WGM = 8;

__host__ __device__ __forceinline__ int lds_byte(int r, int c) { const int st = (r >> 4) * 2 + (c >> 5), rr = r & 15, cc = c & 31, ob = rr * 64 + cc * 2; return st * 1024 + (ob ^ (((ob >> 9) & 1) << 5)); }
__host__ __device__ __forceinline__ void stage_rc(int b, int& R, int& C) { const int st = b / 1024, sb = b % 1024, swz = sb ^ (((sb >> 9) & 1) << 5); R = (st >> 1) * 16 + swz / 64; C = (st & 1) * 32 + (swz % 64) / 2; }
__host__ __device__ __forceinline__ int perm32(int rho) { const int n = rho >> 4, i = rho & 15; return 8 * (i >> 2) + 4 * n + (i & 3); }

struct Unit { int pm, pn, arow, brow, kofs, seg; };
struct Gemm { const bf16_t* A; const bf16_t* Bt; int lda, ldb, K; };

struct StaticOrder {
    int nM, nN, nwg, G, c, rowstep;
    __device__ void init(int nM_, int nN_, int G_, int c_, int rowstep_) { nM = nM_; nN = nN_; nwg = nM * nN; G = G_; c = c_; rowstep = rowstep_; }
    __device__ bool next(int i, Unit& u) const {
        const long L = (long)i * G + c; if (L >= nwg) return false;
        int wgid = (int)L; { const int q = nwg / NXCD, r = nwg % NXCD, xcd = wgid % NXCD, off = wgid / NXCD; wgid = (xcd < r ? xcd * (q + 1) : r * (q + 1) + (xcd - r) * q) + off; }
        const int nig = WGM * nN, gid = wgid / nig, fm = gid * WGM, gsz = (nM - fm) < WGM ? (nM - fm) : WGM;
        u.pm = fm + ((wgid % nig) % gsz); u.pn = (wgid % nig) / gsz; u.arow = u.pm * rowstep; u.brow = u.pn * BM; u.kofs = 0; u.seg = 0; return true;
    }
};
struct SegOrder {
    StaticOrder so; int nseg, klen;
    __device__ void init(int nM_, int nN_, int G_, int c_, int nseg_, int klen_) { so.init(nM_, nN_, G_, c_, BM); nseg = nseg_; klen = klen_; }
    __device__ bool next(int i, Unit& u) const { const int t = i / nseg, s = i - t * nseg; if (!so.next(t, u)) return false; u.kofs = s * klen; u.seg = s; return true; }
};

typedef __bf16 bf16x2_t __attribute__((ext_vector_type(2)));
__device__ __forceinline__ unsigned cvt_pk_bf16(float lo, float hi) { f32x2 v = {lo, hi}; bf16x2_t b = __builtin_convertvector(v, bf16x2_t); return __builtin_bit_cast(unsigned, b); }
__device__ __forceinline__ float bf_lo(unsigned w) { return __uint_as_float(w << 16); }
__device__ __forceinline__ float bf_hi(unsigned w) { return __uint_as_float(w & 0xffff0000u); }
__device__ __forceinline__ u32x4 pack8(const f32x4 a, const f32x4 b) { u32x4 w; w.x = cvt_pk_bf16(a[0], a[1]); w.y = cvt_pk_bf16(a[2], a[3]); w.z = cvt_pk_bf16(b[0], b[1]); w.w = cvt_pk_bf16(b[2], b[3]); return w; }
__device__ __forceinline__ void unpack8(const u32x4 w, f32x4& a, f32x4& b) { a = (f32x4){bf_lo(w.x), bf_hi(w.x), bf_lo(w.y), bf_hi(w.y)}; b = (f32x4){bf_lo(w.z), bf_hi(w.z), bf_lo(w.w), bf_hi(w.w)}; }
__device__ __forceinline__ f32x2 gelu_pk(f32x2 v) {
    const f32x2 av = __builtin_elementwise_abs(v), d = av * 0.2316418882f + 1.0f;
    f32x2 t; t.x = __builtin_amdgcn_rcpf(d.x); t.y = __builtin_amdgcn_rcpf(d.y);
    f32x2 q = t * 0.5307027145f + (-0.7265760135f); q = q * t + 0.7107068705f; q = q * t + (-0.142248368f); q = q * t + 0.127414796f; q = q * t;
    const f32x2 s = (v * v) * (-0.72134752044f);
    f32x2 e; e.x = __builtin_amdgcn_exp2f(s.x); e.y = __builtin_amdgcn_exp2f(s.y);
    const f32x2 m = v * (q * e), r = v - m;
    f32x2 o; o.x = v.x < 0.f ? m.x : r.x; o.y = v.y < 0.f ? m.y : r.y; return o;
}
__device__ __forceinline__ f32x4 gelu4(f32x4 v) { f32x2 a = gelu_pk((f32x2){v[0], v[1]}), b = gelu_pk((f32x2){v[2], v[3]}); return (f32x4){a.x, a.y, b.x, b.y}; }

template <class Epi, class Sched, bool ALIGN_EPI>
__device__ __forceinline__ void gemm_phase(const int tid, PG8_LAS unsigned char* lds, PG8_LAS unsigned char* xlds, const Gemm g, const Sched& S, const Epi& E) {
    const int wid = __builtin_amdgcn_readfirstlane(tid >> 6), lane = tid & 63, wr = wid >> 2, wc = wid & 3, fr = lane & 15, fq = lane >> 4;
    const int K = g.K, nt = K / BK;
    unsigned voffA[2], voffB[2];
#pragma unroll
    for (int i = 0; i < 2; ++i) { int R, C; stage_rc(tid * 16 + i * 8192, R, C); const int Rb = Epi::PERM ? ((R & ~31) + perm32(R & 31)) : R;
        voffA[i] = (unsigned)(R * g.lda + C) * 2u; voffB[i] = (unsigned)(Rb * g.ldb + C) * 2u; }
    const size_t kstep = (size_t)(BK * 2);
    const size_t hstepA = (size_t)HALF * g.lda * 2, hstepB = (size_t)HALF * g.ldb * 2;
    const unsigned ldsw = (unsigned)wid * 1024u;
    const int aoff = lds_byte(wr * 64 + fr, fq * 8), boff = lds_byte(wc * 32 + fr, fq * 8);
#define PG8_SA(b, h) (((b) * 2 + (h)) * HTB)
#define PG8_SB(b, h) ((4 + (b) * 2 + (h)) * HTB)
#define PG8_STAGE(bufoff, gbase, voff) do { _Pragma("unroll") for (int _i = 0; _i < 2; ++_i) \
        __builtin_amdgcn_global_load_lds((const unsigned*)((const char*)(gbase) + (voff)[_i]), (PG8_LAS unsigned*)(lds + (bufoff) + ldsw + _i * 8192), 16, 0, 0); } while (0)
#define PG8_LDA(dst, b, h) do { _Pragma("unroll") for (int m = 0; m < 4; ++m) _Pragma("unroll") for (int k = 0; k < 2; ++k) dst[m][k] = *(const PG8_LAS bf16x8*)(lds + PG8_SA(b, h) + aoff + m * 2048 + k * 1024); } while (0)
#define PG8_LDB(dst, b, h) do { _Pragma("unroll") for (int n = 0; n < 2; ++n) _Pragma("unroll") for (int k = 0; k < 2; ++k) dst[n][k] = *(const PG8_LAS bf16x8*)(lds + PG8_SB(b, h) + boff + n * 2048 + k * 1024); } while (0)
#define PG8_MMA(ai, bj, At, Bt) do { __builtin_amdgcn_s_setprio(1); _Pragma("unroll") for (int m = 0; m < 4; ++m) _Pragma("unroll") for (int n = 0; n < 2; ++n) _Pragma("unroll") for (int k = 0; k < 2; ++k) \
        acc[ai][bj][m][n] = __builtin_amdgcn_mfma_f32_16x16x32_bf16(Bt[n][k], At[m][k], acc[ai][bj][m][n], 0, 0, 0); __builtin_amdgcn_s_setprio(0); } while (0)
#define PG8_WAIT_V(n) asm volatile("s_waitcnt vmcnt(" #n ")" ::: "memory")
#define PG8_WAIT_L(n) asm volatile("s_waitcnt lgkmcnt(" #n ")" ::: "memory")
#define PG8_BAR __builtin_amdgcn_s_barrier()
#define PG8_SCHED __builtin_amdgcn_sched_barrier(0)
    Unit cur, nxt; int ui = 0;
    if (!S.next(0, cur)) return;
    f32x4 acc[2][2][4][2];
#pragma unroll
    for (int a = 0; a < 2; ++a)
#pragma unroll
        for (int b = 0; b < 2; ++b)
#pragma unroll
            for (int m = 0; m < 4; ++m)
#pragma unroll
                for (int n = 0; n < 2; ++n) acc[a][b][m][n] = (f32x4){0.f, 0.f, 0.f, 0.f};
    bf16x8 At[4][2], B0[2][2], B1[2][2];
    const char* cA = (const char*)g.A + ((size_t)cur.arow * g.lda + cur.kofs) * 2; const char* cB = (const char*)g.Bt + ((size_t)cur.brow * g.ldb + cur.kofs) * 2;
    PG8_STAGE(PG8_SB(0, 0), cB, voffB); PG8_STAGE(PG8_SB(0, 1), cB + hstepB, voffB); PG8_STAGE(PG8_SA(0, 0), cA, voffA); PG8_STAGE(PG8_SA(0, 1), cA + hstepA, voffA);
    if (wr == 1) PG8_BAR;
    PG8_WAIT_V(2); PG8_BAR;
    PG8_STAGE(PG8_SB(1, 0), cB + kstep, voffB); PG8_STAGE(PG8_SA(1, 0), cA + kstep, voffA); PG8_STAGE(PG8_SB(1, 1), cB + hstepB + kstep, voffB);
    PG8_WAIT_V(6); PG8_BAR;
    for (;;) {
        const bool has_next = S.next(ui + 1, nxt);
        const char* nA = has_next ? (const char*)g.A + ((size_t)nxt.arow * g.lda + nxt.kofs) * 2 : cA; const char* nB = has_next ? (const char*)g.Bt + ((size_t)nxt.brow * g.ldb + nxt.kofs) * 2 : cB;
        for (int t = 0; t < nt; t += 2) {
            const bool last = (t == nt - 2);
            const char* a1 = cA + (size_t)(t + 1) * kstep;
            const char* a2 = last ? nA : cA + (size_t)(t + 2) * kstep; const char* b2 = last ? nB : cB + (size_t)(t + 2) * kstep;
            const char* a3 = a2 + kstep; const char* b3 = b2 + kstep;
            PG8_LDB(B0, 0, 0); PG8_LDB(B1, 0, 1); PG8_SCHED; PG8_LDA(At, 0, 0); PG8_STAGE(PG8_SA(1, 1), a1 + hstepA, voffA);
            PG8_WAIT_V(8); PG8_WAIT_L(0); PG8_BAR; PG8_MMA(0, 0, At, B0); PG8_MMA(0, 1, At, B1); PG8_BAR; PG8_SCHED;
            PG8_LDA(At, 0, 1); PG8_STAGE(PG8_SB(0, 0), b2, voffB); PG8_STAGE(PG8_SB(0, 1), b2 + hstepB, voffB); PG8_STAGE(PG8_SA(0, 0), a2, voffA);
            PG8_WAIT_V(8); PG8_WAIT_L(0); PG8_BAR; PG8_MMA(1, 0, At, B0); PG8_MMA(1, 1, At, B1); PG8_BAR; PG8_SCHED;
            PG8_LDB(B0, 1, 0); PG8_LDB(B1, 1, 1); PG8_SCHED; PG8_LDA(At, 1, 0); PG8_STAGE(PG8_SA(0, 1), a2 + hstepA, voffA);
            PG8_WAIT_V(8); PG8_WAIT_L(0); PG8_BAR; PG8_MMA(0, 0, At, B0); PG8_MMA(0, 1, At, B1); PG8_BAR; PG8_SCHED;
            PG8_LDA(At, 1, 1); PG8_STAGE(PG8_SB(1, 0), b3, voffB); PG8_STAGE(PG8_SB(1, 1), b3 + hstepB, voffB); PG8_STAGE(PG8_SA(1, 0), a3, voffA);
            PG8_WAIT_V(8); PG8_WAIT_L(0); PG8_BAR; PG8_MMA(1, 0, At, B0); PG8_MMA(1, 1, At, B1); PG8_BAR; PG8_SCHED;
        }
        if constexpr (ALIGN_EPI) { if (wr == 0) PG8_BAR; }
        if constexpr (!Epi::AFTER_DRAIN) { E(acc, cur, wr, wc, fr, fq, xlds, wid, lane); }
        if (!has_next) break;
#pragma unroll
        for (int a = 0; a < 2; ++a)
#pragma unroll
            for (int b = 0; b < 2; ++b)
#pragma unroll
                for (int m = 0; m < 4; ++m)
#pragma unroll
                    for (int n = 0; n < 2; ++n) acc[a][b][m][n] = (f32x4){0.f, 0.f, 0.f, 0.f};
        cur = nxt; cA = nA; cB = nB; ++ui;
        if constexpr (ALIGN_EPI) { if (wr == 1) PG8_BAR; }
    }
    PG8_WAIT_V(0);
    if constexpr (!ALIGN_EPI) { if (wr == 0) PG8_BAR; }
    PG8_BAR;
    if constexpr (Epi::AFTER_DRAIN) { E.fused(acc, cur, wr, wc, fr, fq, lds, wid, lane); }
#undef PG8_SA
#undef PG8_SB
#undef PG8_STAGE
#undef PG8_LDA
#undef PG8_LDB
#undef PG8_MMA
#undef PG8_WAIT_V
#undef PG8_WAIT_L
#undef PG8_BAR
#undef PG8_SCHED
}

typedef const f32x4 (&AccRef)[2][2][4][2];
#define PG8_EPI_ARGS AccRef acc, const Unit& u, int wr, int wc, int fr, int fq, PG8_LAS unsigned char* xlds, int wid, int lane

struct EpiInProj {
    static constexpr bool PERM = true, AFTER_DRAIN = false;
    bf16_t *U, *YS, *DK, *DV, *SK, *SV; const float *cs, *sn;
    __device__ __forceinline__ void operator()(PG8_EPI_ARGS) const {
        const int pn = u.pn, row0 = u.pm * BM + wr * 64 + fr;
        int kind, ld, d0, d1; bf16_t* base;
        if (pn < 4)       { kind = 0; base = U;  ld = 512;  d0 = 128 * pn + 32 * wc + 8 * fq; d1 = 0; }
        else if (pn < 6)  { kind = 1; base = YS; ld = 1536; d0 = (pn - 4) * 256 + 32 * wc + 8 * fq; d1 = d0 + 128; }
        else if (pn < 8)  { kind = 2; base = YS; ld = 1536; d0 = 512 + (4 * (pn - 6) + wc) * 64 + 8 * fq; d1 = d0 + 32; }
        else if (pn < 10) { kind = 2; base = DK; ld = 512;  d0 = (4 * (pn - 8) + wc) * 64 + 8 * fq; d1 = d0 + 32; }
        else if (pn < 12) { kind = 1; base = DV; ld = 512;  d0 = (pn - 10) * 256 + 32 * wc + 8 * fq; d1 = d0 + 128; }
        else if (pn < 14) { kind = 2; base = YS; ld = 1536; d0 = 1024 + (4 * (pn - 12) + wc) * 64 + 8 * fq; d1 = d0 + 32; }
        else if (wc < 2)  { kind = 2; base = SK; ld = 128;  d0 = wc * 64 + 8 * fq; d1 = d0 + 32; }
        else              { kind = 1; base = SV; ld = 128;  d0 = 32 * (wc - 2) + 8 * fq; d1 = d0 + 64; }
#pragma unroll
        for (int ai = 0; ai < 2; ++ai)
#pragma unroll
            for (int m = 0; m < 4; ++m) {
                const int row = row0 + ai * HALF + m * 16;
                bf16_t* rp = base + (size_t)row * ld;
                const f32x4 x0a = acc[ai][0][m][0], x0b = acc[ai][0][m][1], x1a = acc[ai][1][m][0], x1b = acc[ai][1][m][1];
                if (kind == 0) { *(u32x4*)(rp + d0) = pack8(x0a * x1a, x0b * x1b); }
                else if (kind == 1) { *(u32x4*)(rp + d0) = pack8(x0a, x0b); *(u32x4*)(rp + d1) = pack8(x1a, x1b); }
                else {
                    const f32x4 ca = *(const f32x4*)(cs + (size_t)row * 32 + 8 * fq), cb = *(const f32x4*)(cs + (size_t)row * 32 + 8 * fq + 4);
                    const f32x4 sa = *(const f32x4*)(sn + (size_t)row * 32 + 8 * fq), sb = *(const f32x4*)(sn + (size_t)row * 32 + 8 * fq + 4);
                    *(u32x4*)(rp + d0) = pack8(x0a * ca - x1a * sa, x0b * cb - x1b * sb);
                    *(u32x4*)(rp + d1) = pack8(x1a * ca + x0a * sa, x1b * cb + x0b * sb);
                }
            }
    }
};

struct EpiGates {
    static constexpr bool PERM = true, AFTER_DRAIN = false;
    bf16_t* G; const float* bias;
    __device__ __forceinline__ void operator()(PG8_EPI_ARGS) const {
        const int row0 = u.pm * BM + wr * 64 + fr, col0 = u.pn * BM + wc * 32 + 8 * fq;
        f32x4 bv[2][2];
#pragma unroll
        for (int bj = 0; bj < 2; ++bj)
#pragma unroll
            for (int n = 0; n < 2; ++n) bv[bj][n] = *(const f32x4*)(bias + col0 + bj * HALF + 4 * n);
#pragma unroll
        for (int ai = 0; ai < 2; ++ai)
#pragma unroll
            for (int m = 0; m < 4; ++m) { bf16_t* rp = G + (size_t)(row0 + ai * HALF + m * 16) * 3072 + col0;
#pragma unroll
                for (int bj = 0; bj < 2; ++bj) { f32x4 v[2];
#pragma unroll
                    for (int n = 0; n < 2; ++n) { const f32x4 x = acc[ai][bj][m][n] + bv[bj][n];
#pragma unroll
                        for (int e = 0; e < 4; ++e) v[n][e] = __builtin_amdgcn_rcpf(1.0f + __builtin_amdgcn_exp2f(x[e] * -1.4426950408889634f)); }
                    *(u32x4*)(rp + bj * HALF) = pack8(v[0], v[1]); } }
    }
};

struct EpiBranch {
    static constexpr bool PERM = true, AFTER_DRAIN = false;
    bf16_t* O; const bf16_t* GT;
    __device__ __forceinline__ void operator()(PG8_EPI_ARGS) const {
        const int row0 = u.pm * BM + wr * 64 + fr, col0 = u.pn * BM + wc * 32 + 8 * fq, seg = u.seg;
#pragma unroll
        for (int ai = 0; ai < 2; ++ai)
#pragma unroll
            for (int m = 0; m < 4; ++m) { const int row = row0 + ai * HALF + m * 16;
#pragma unroll
                for (int bj = 0; bj < 2; ++bj) {
                    const u32x4 gw = *(const u32x4*)(GT + (size_t)row * 3072 + seg * 1024 + col0 + bj * HALF);
                    f32x4 ga, gb; unpack8(gw, ga, gb);
                    f32x4 va = ga * acc[ai][bj][m][0], vb = gb * acc[ai][bj][m][1];
                    bf16_t* op = O + (size_t)row * 1024 + col0 + bj * HALF;
                    if (seg > 0) { const u32x4 pw = *(const u32x4*)op; f32x4 pa, pb; unpack8(pw, pa, pb); va += pa; vb += pb; }
                    *(u32x4*)op = pack8(va, vb); } }
    }
};

struct EpiResid {
    static constexpr bool PERM = true, AFTER_DRAIN = false;
    float* H; float alpha;
    __device__ __forceinline__ void operator()(PG8_EPI_ARGS) const {
        const int row0 = u.pm * BM + wr * 64 + fr, col0 = u.pn * BM + wc * 32 + 8 * fq;
#pragma unroll
        for (int ai = 0; ai < 2; ++ai)
#pragma unroll
            for (int m = 0; m < 4; ++m) { float* rp = H + (size_t)(row0 + ai * HALF + m * 16) * 1024 + col0;
#pragma unroll
                for (int bj = 0; bj < 2; ++bj)
#pragma unroll
                    for (int n = 0; n < 2; ++n) { f32x4* p = (f32x4*)(rp + bj * HALF + 4 * n); const f32x4 h = *p; *p = h * alpha + acc[ai][bj][m][n]; } }
    }
};

__device__ __forceinline__ float dpp_ror1(float v)  { return __int_as_float(__builtin_amdgcn_update_dpp(0, __float_as_int(v), 0x121, 0xf, 0xf, false)); }
__device__ __forceinline__ float dpp_ror15(float v) { return __int_as_float(__builtin_amdgcn_update_dpp(0, __float_as_int(v), 0x12F, 0xf, 0xf, false)); }
__device__ __forceinline__ f32x4 ror1_4(f32x4 v)  { return (f32x4){dpp_ror1(v[0]), dpp_ror1(v[1]), dpp_ror1(v[2]), dpp_ror1(v[3])}; }
__device__ __forceinline__ f32x4 ror15_4(f32x4 v) { return (f32x4){dpp_ror15(v[0]), dpp_ror15(v[1]), dpp_ror15(v[2]), dpp_ror15(v[3])}; }
struct EpiUpConv {
    static constexpr bool PERM = true, AFTER_DRAIN = false;
    bf16_t* ACT; const float* cw;
    static constexpr int S = 16384;
    __device__ __forceinline__ void operator()(AccRef acc, const Unit& u, int wr_, int wc_, int fr_, int fq_, PG8_LAS unsigned char* xlds, int wid_, int lane_) const {
        int ln; asm volatile("v_mbcnt_lo_u32_b32 %0, -1, 0\n\tv_mbcnt_hi_u32_b32 %0, -1, %0" : "=v"(ln));
        int wid = wid_; asm volatile("" : "+s"(wid));
        const int fr = ln & 15, fq = ln >> 4, wr = wid >> 2, wc = wid & 3;
        (void)wr_; (void)wc_; (void)fr_; (void)fq_; (void)lane_;
        PG8_LAS f32x4* X = (PG8_LAS f32x4*)xlds;
        if (fr == 0) {
#pragma unroll
            for (int ai = 0; ai < 2; ++ai)
#pragma unroll
                for (int bj = 0; bj < 2; ++bj)
#pragma unroll
                    for (int n = 0; n < 2; ++n) X[((((wid * 2 + ai) * 2 + 0) * 2 + bj) * 2 + n) * 4 + fq] = acc[ai][bj][0][n];
        }
        if (fr == 15) {
#pragma unroll
            for (int ai = 0; ai < 2; ++ai)
#pragma unroll
                for (int bj = 0; bj < 2; ++bj)
#pragma unroll
                    for (int n = 0; n < 2; ++n) X[((((wid * 2 + ai) * 2 + 1) * 2 + bj) * 2 + n) * 4 + fq] = acc[ai][bj][3][n];
        }
        asm volatile("s_waitcnt lgkmcnt(0)" ::: "memory"); __builtin_amdgcn_s_barrier(); asm volatile("" ::: "memory");
        const int pw = (1 - wr) * 4 + wc;
        const bool f0 = (fr == 0), f15 = (fr == 15);
        const int ubr = S - 254 * u.pm - 1; const unsigned ub = (unsigned)(ubr < 253 ? ubr : 253);
#pragma unroll
        for (int ai = 0; ai < 2; ++ai) {
            const int aip = (ai == 0) ? 0 : wr, ain = (ai == 0) ? wr : 1;
            const bool pvalid = !(ai == 0 && wr == 0), nvalid = !(ai == 1 && wr == 1);
#pragma unroll
            for (int n = 0; n < 2; ++n) {
                asm volatile("" ::: "memory");
                int zr = 0; asm volatile("" : "+v"(zr));
                const int colg = 128 * u.pn + 32 * wc + 8 * fq + 4 * n;
                const float* wp = cw + colg;
                const f32x4 g0 = *(const f32x4*)(wp), g1 = *(const f32x4*)(wp + 5632), g2 = *(const f32x4*)(wp + 2 * 5632);
                const f32x4 u0 = *(const f32x4*)(wp + 2816), u1 = *(const f32x4*)(wp + 2816 + 5632), u2 = *(const f32x4*)(wp + 2816 + 2 * 5632);
                f32x4 hpg = X[((((pw * 2 + aip) * 2 + 1) * 2 + 0) * 2 + n) * 4 + fq], hpu = X[((((pw * 2 + aip) * 2 + 1) * 2 + 1) * 2 + n) * 4 + fq];
                f32x4 hng = X[((((pw * 2 + ain) * 2 + 0) * 2 + 0) * 2 + n) * 4 + fq], hnu = X[((((pw * 2 + ain) * 2 + 0) * 2 + 1) * 2 + n) * 4 + fq];
                if (!pvalid) { hpg = (f32x4){0.f, 0.f, 0.f, 0.f}; hpu = hpg; }
                if (!nvalid) { hng = (f32x4){0.f, 0.f, 0.f, 0.f}; hnu = hng; }
                f32x4 rpg = hpg, rpu = hpu, rcg = ror15_4(acc[ai][0][0][n]), rcu = ror15_4(acc[ai][1][0][n]);
#pragma unroll
                for (int m = 0; m < 4; ++m) {
                    const f32x4 xg = acc[ai][0][m][n], xu = acc[ai][1][m][n];
                    const f32x4 rrg = ror1_4(xg), rru = ror1_4(xu);
                    f32x4 rng = hng, rnu = hnu; if (m < 3) { rng = ror15_4(acc[ai][0][m + 1][n]); rnu = ror15_4(acc[ai][1][m + 1][n]); }
                    f32x4 pg, ng, pu, nu;
#pragma unroll
                    for (int e = 0; e < 4; ++e) { pg[e] = f0 ? rpg[e] : rrg[e]; ng[e] = f15 ? rng[e] : rcg[e]; pu[e] = f0 ? rpu[e] : rru[e]; nu[e] = f15 ? rnu[e] : rcu[e]; }
                    const f32x4 yg = g0 * pg + g1 * xg + g2 * ng, yu = u0 * pu + u1 * xu + u2 * nu;
                    rpg = rrg; rpu = rru; rcg = rng; rcu = rnu;
                    const int r = ai * HALF + wr * 64 + m * 16 + fr + zr, grow = 254 * u.pm - 1 + r;
                    const f32x4 a = gelu4(yg) * yu;
                    u32x2 w; w.x = cvt_pk_bf16(a[0], a[1]); w.y = cvt_pk_bf16(a[2], a[3]);
                    if ((unsigned)(r - 1) <= ub) *(u32x2*)(ACT + (size_t)grow * 2816 + colg) = w;
                }
            }
        }
    }
};
}

namespace att {
typedef unsigned short bf16_t;
using bf16x8 = __attribute__((ext_vector_type(8))) short;
using s16x4  = __attribute__((ext_vector_type(4))) short;
using f32x16 = __attribute__((ext_vector_type(16))) float;
using u32x4  = __attribute__((ext_vector_type(4))) unsigned;
using u32x2  = __attribute__((ext_vector_type(2))) unsigned;
constexpr int NW = 8, QBLK = 32, KVBLK = 64;
constexpr int SHM_V = KVBLK * 128 * 2, SHM_K = KVBLK * 64 * 2, SHM_ATTN = 2 * SHM_V + 2 * SHM_K;
constexpr float SCALE = 0.125f;
constexpr float CEXP = SCALE * 1.4426950408889634f;
constexpr float THR = 8.f;
#define KSWZ64(row, cb) ((row) * 128 + ((cb) ^ ((((row) >> 1) & 7) << 4)))
#define ATT_SBAR() __builtin_amdgcn_sched_barrier(0)
__device__ __forceinline__ int crow(int r, int hi) { return (r & 3) + 8 * (r >> 2) + 4 * hi; }
__device__ __forceinline__ unsigned cvtpk(float lo, float hi) { return pg8::cvt_pk_bf16(lo, hi); }

template <bool MASK>
__device__ __forceinline__ void partialSM(f32x16& p0, f32x16& p1, float& m_reg, float& mn, float& alpha, int dq, int hi, int win) {
  if (MASK) {
#pragma unroll
    for (int r = 0; r < 16; ++r) { const int d0 = dq + crow(r, hi), d1 = d0 + 32;
      if (d0 > win || d0 < -win) p0[r] = -INFINITY; if (d1 > win || d1 < -win) p1[r] = -INFINITY; }
  }
  float pmax = p0[0];
#pragma unroll
  for (int r = 1; r < 16; ++r) pmax = fmaxf(pmax, p0[r]);
#pragma unroll
  for (int r = 0; r < 16; ++r) pmax = fmaxf(pmax, p1[r]);
  { auto rr = __builtin_amdgcn_permlane32_swap(__float_as_uint(pmax), __float_as_uint(pmax), false, false);
    pmax = fmaxf(__uint_as_float(rr[0]), __uint_as_float(rr[1])); }
  if (__builtin_expect(__all(pmax - m_reg <= THR / SCALE), 1)) { mn = m_reg; alpha = 1.f; }
  else { mn = fmaxf(m_reg, pmax); alpha = __builtin_amdgcn_exp2f((m_reg - mn) * CEXP); m_reg = mn; }
  const float mnC = -mn * CEXP;
#pragma unroll
  for (int r = 0; r < 16; ++r) p0[r] = fmaf(p0[r], CEXP, mnC);
#pragma unroll
  for (int r = 0; r < 16; ++r) p1[r] = fmaf(p1[r], CEXP, mnC);
#pragma unroll
  for (int r = 0; r < 16; ++r) p0[r] = __builtin_amdgcn_exp2f(p0[r]);
}
__device__ __forceinline__ void finishSM(f32x16& p0, f32x16& p1, float alpha, float& l_reg, bf16x8& pa0, bf16x8& pa1, bf16x8& pa2, bf16x8& pa3) {
#pragma unroll
  for (int r = 0; r < 16; ++r) p1[r] = __builtin_amdgcn_exp2f(p1[r]);
  float ps = 0;
#pragma unroll
  for (int r = 0; r < 16; ++r) ps += p0[r];
#pragma unroll
  for (int r = 0; r < 16; ++r) ps += p1[r];
  { auto rr = __builtin_amdgcn_permlane32_swap(__float_as_uint(ps), __float_as_uint(ps), false, false);
    ps = __uint_as_float(rr[0]) + __uint_as_float(rr[1]); }
  l_reg = l_reg * alpha + ps;
#define ATT_PK4(P, BASE, OUT) do { unsigned a0 = cvtpk(P[BASE + 0], P[BASE + 1]), a1 = cvtpk(P[BASE + 2], P[BASE + 3]);   \
    unsigned b0 = cvtpk(P[BASE + 4], P[BASE + 5]), b1 = cvtpk(P[BASE + 6], P[BASE + 7]);                              \
    auto r0 = __builtin_amdgcn_permlane32_swap(a0, b0, false, false); auto r1 = __builtin_amdgcn_permlane32_swap(a1, b1, false, false); \
    u32x4 w = {r0[0], r1[0], r0[1], r1[1]}; OUT = *reinterpret_cast<bf16x8*>(&w); } while (0)
  ATT_PK4(p0, 0, pa0); ATT_PK4(p0, 8, pa1); ATT_PK4(p1, 0, pa2); ATT_PK4(p1, 8, pa3);
#undef ATT_PK4
}
__device__ __forceinline__ void qkt(f32x16& p0, f32x16& p1, const char* Ks, const bf16x8* qr, int r32, int hi) {
  p0 = f32x16{}; p1 = f32x16{};
#pragma unroll
  for (int d0 = 0; d0 < 4; ++d0) { const int cb = (d0 * 16 + hi * 8) * 2;
    const bf16x8 b0 = *reinterpret_cast<const bf16x8*>(Ks + KSWZ64(r32, cb));
    const bf16x8 b1 = *reinterpret_cast<const bf16x8*>(Ks + KSWZ64(32 + r32, cb));
    p0 = __builtin_amdgcn_mfma_f32_32x32x16_bf16(b0, qr[d0], p0, 0, 0, 0);
    p1 = __builtin_amdgcn_mfma_f32_32x32x16_bf16(b1, qr[d0], p1, 0, 0, 0); }
}
__device__ __forceinline__ int v_st(int k, int c) { const int kk = (k & ~0xC) | ((k & 4) << 1) | ((k & 8) >> 1); return ((kk >> 3) * 4 + (c >> 5)) * 512 + ((kk & 7) * 32 + (c & 31)) * 2; }
__device__ __forceinline__ int v_rd_base(int lane) { return ((lane & 3) << 3) | (((lane >> 2) & 3) << 6) | (((lane >> 4) & 1) << 5) | (((lane >> 5) & 1) << 8); }
constexpr int v_rd_off(int d0, int ks, int half) { return d0 * 512 + ks * 4096 + half * 2048; }
template <int OFF> __device__ __forceinline__ s16x4 tr_read(int vb) {
  s16x4 r; asm volatile("ds_read_b64_tr_b16 %0, %1 offset:%2" : "=&v"(r) : "v"(vb), "i"(OFF) : "memory"); return r;
}
template <int D0> __device__ __forceinline__ void pv_one(f32x16& od, int vb, bf16x8 pa0, bf16x8 pa1, bf16x8 pa2, bf16x8 pa3) {
  const s16x4 l0 = tr_read<v_rd_off(D0, 0, 0)>(vb), h0 = tr_read<v_rd_off(D0, 0, 1)>(vb), l1 = tr_read<v_rd_off(D0, 1, 0)>(vb), h1 = tr_read<v_rd_off(D0, 1, 1)>(vb);
  const s16x4 l2 = tr_read<v_rd_off(D0, 2, 0)>(vb), h2 = tr_read<v_rd_off(D0, 2, 1)>(vb), l3 = tr_read<v_rd_off(D0, 3, 0)>(vb), h3 = tr_read<v_rd_off(D0, 3, 1)>(vb);
  asm volatile("s_waitcnt lgkmcnt(0)" ::: "memory"); ATT_SBAR();
#define ATT_PK(L, H) (bf16x8){L[0], L[1], L[2], L[3], H[0], H[1], H[2], H[3]}
  od = __builtin_amdgcn_mfma_f32_32x32x16_bf16(ATT_PK(l0, h0), pa0, od, 0, 0, 0);
  od = __builtin_amdgcn_mfma_f32_32x32x16_bf16(ATT_PK(l1, h1), pa1, od, 0, 0, 0);
  od = __builtin_amdgcn_mfma_f32_32x32x16_bf16(ATT_PK(l2, h2), pa2, od, 0, 0, 0);
  od = __builtin_amdgcn_mfma_f32_32x32x16_bf16(ATT_PK(l3, h3), pa3, od, 0, 0, 0);
#undef ATT_PK
}
template <int DV> __device__ __forceinline__ void pv_all(f32x16* o, int vb, bf16x8 pa0, bf16x8 pa1, bf16x8 pa2, bf16x8 pa3) {
  pv_one<0>(o[0], vb, pa0, pa1, pa2, pa3); pv_one<1>(o[1], vb, pa0, pa1, pa2, pa3);
  if constexpr (DV == 128) { pv_one<2>(o[2], vb, pa0, pa1, pa2, pa3); pv_one<3>(o[3], vb, pa0, pa1, pa2, pa3); }
}

template <int DV, bool MASK, int SDEPTH, int ldk, int ldv>
__device__ __forceinline__ void attn_core(const int tid, const bf16_t* __restrict__ Qw, const bf16_t* __restrict__ Kh, const bf16_t* __restrict__ Vh, int NT,
                                          float m_init, float l_init, int dq0, int win, char* lds, f32x16 (&o)[DV / 32], float& l_out) {
  const int lane = tid & 63, r32 = lane & 31, hi = lane >> 5;
  char* V_lds = lds; char* K_lds = lds + 2 * SHM_V;
  float m_reg = m_init, l_reg = l_init;
#pragma unroll
  for (int d = 0; d < DV / 32; ++d) o[d] = f32x16{};
  bf16x8 qr[4];
#pragma unroll
  for (int d0 = 0; d0 < 4; ++d0) qr[d0] = *reinterpret_cast<const bf16x8*>(Qw + d0 * 16);
  const int kr = tid >> 3, kc8 = (tid & 7) * 8, kdst = KSWZ64(kr, kc8 * 2);
  const int sr = (DV == 128) ? (tid >> 4) : (tid >> 3), sc = (DV == 128) ? (tid & 15) * 8 : (tid & 7) * 8;
  const int vst0 = v_st(sr, sc), vst1 = v_st(32 + sr, sc);
  const int vb0 = (int)(uintptr_t)V_lds + v_rd_base(lane);
  struct { bf16x8 ks, vs0, vs1; } sr_[SDEPTH];
#define ATT_SLOAD(i, k0) do { sr_[i].ks = *reinterpret_cast<const bf16x8*>(Kh + (size_t)((k0) + kr) * ldk + kc8); \
    sr_[i].vs0 = *reinterpret_cast<const bf16x8*>(Vh + (size_t)((k0) + sr) * ldv + sc); \
    if constexpr (DV == 128) sr_[i].vs1 = *reinterpret_cast<const bf16x8*>(Vh + (size_t)((k0) + 32 + sr) * ldv + sc); } while (0)
#define ATT_SWRITE(b, i) do { *(bf16x8*)(K_lds + (b) * SHM_K + kdst) = sr_[i].ks; *(bf16x8*)(V_lds + (b) * SHM_V + vst0) = sr_[i].vs0; \
    if constexpr (DV == 128) *(bf16x8*)(V_lds + (b) * SHM_V + vst1) = sr_[i].vs1; } while (0)
#define ATT_SWAIT() do { if constexpr (SDEPTH == 1) asm volatile("s_waitcnt vmcnt(0)" ::: "memory"); else if constexpr (DV == 128) asm volatile("s_waitcnt vmcnt(3)" ::: "memory"); else asm volatile("s_waitcnt vmcnt(2)" ::: "memory"); } while (0)
#define ATT_RESC(a) do { if (__any((a) < 1.f)) { _Pragma("unroll") for (int d = 0; d < DV / 32; ++d) _Pragma("unroll") for (int r = 0; r < 16; ++r) o[d][r] *= (a); } } while (0)
  f32x16 pA0, pA1, pB0, pB1; float mnA, mnB, alA, alB; bf16x8 pa0, pa1, pa2, pa3;
  constexpr int SE = 0, SO = SDEPTH - 1;
  ATT_SLOAD(SE, 0); asm volatile("s_waitcnt vmcnt(0)" ::: "memory"); ATT_SWRITE(0, SE); __syncthreads();
  qkt(pA0, pA1, K_lds, qr, r32, hi); partialSM<MASK>(pA0, pA1, m_reg, mnA, alA, dq0, hi, win);
  ATT_SLOAD(SO, KVBLK); if constexpr (SDEPTH == 2) { if (2 < NT) ATT_SLOAD(SE, 2 * KVBLK); }
  ATT_SWAIT(); ATT_SWRITE(1, SO); __syncthreads();
  ATT_RESC(alA);
  for (int j = 1; j + 1 < NT; j += 2) {
    ATT_SBAR(); qkt(pB0, pB1, K_lds + SHM_K, qr, r32, hi);
    finishSM(pA0, pA1, alA, l_reg, pa0, pa1, pa2, pa3); ATT_SBAR();
    ATT_SLOAD(SO, (j + SDEPTH) * KVBLK); ATT_SBAR();
    pv_all<DV>(o, vb0, pa0, pa1, pa2, pa3); partialSM<MASK>(pB0, pB1, m_reg, mnB, alB, dq0 + j * KVBLK, hi, win);
    __syncthreads(); ATT_SWAIT(); ATT_SWRITE(0, SE);
    ATT_RESC(alB); __syncthreads();
    ATT_SBAR(); qkt(pA0, pA1, K_lds, qr, r32, hi);
    finishSM(pB0, pB1, alB, l_reg, pa0, pa1, pa2, pa3); ATT_SBAR();
    if (SDEPTH == 1 || j + 3 < NT) ATT_SLOAD(SE, (j + 1 + SDEPTH) * KVBLK); ATT_SBAR();
    pv_all<DV>(o, vb0 + SHM_V, pa0, pa1, pa2, pa3); partialSM<MASK>(pA0, pA1, m_reg, mnA, alA, dq0 + (j + 1) * KVBLK, hi, win);
    __syncthreads(); ATT_SWAIT(); ATT_SWRITE(1, SO);
    ATT_RESC(alA); __syncthreads();
  }
  ATT_SBAR(); qkt(pB0, pB1, K_lds + SHM_K, qr, r32, hi);
  finishSM(pA0, pA1, alA, l_reg, pa0, pa1, pa2, pa3); ATT_SBAR();
  pv_all<DV>(o, vb0, pa0, pa1, pa2, pa3); partialSM<MASK>(pB0, pB1, m_reg, mnB, alB, dq0 + (NT - 1) * KVBLK, hi, win);
  ATT_RESC(alB);
  finishSM(pB0, pB1, alB, l_reg, pa0, pa1, pa2, pa3); ATT_SBAR();
  pv_all<DV>(o, vb0 + SHM_V, pa0, pa1, pa2, pa3);
  l_out = l_reg;
#undef ATT_SLOAD
#undef ATT_SWRITE
#undef ATT_SWAIT
#undef ATT_RESC
}
}

constexpr int NWAVES = 8;
constexpr int SEQ = 16384, DM = 1024, DEPTH = 2, DIN = 3840, NGATE = 3072, DFF = 2816, NUP = 2 * DFF;
constexpr float LN_EPS = 1e-5f;
constexpr float ALPHA = 1.4142135623730951f;
constexpr int NPHASE = 1 + 9 * DEPTH;

constexpr size_t MiB = 1u << 20;
constexpr size_t WS_CTL = 0, CTL_ZERO_BYTES = 1 * MiB;
constexpr size_t WS_COS = 1 * MiB, WS_SIN = 3 * MiB;
constexpr size_t WS_W = 5 * MiB, W_LAYER = 35 * MiB;
constexpr size_t WO_IN = 0, WO_G = 7864320, WO_BR = WO_G + 6 * MiB, WO_O = WO_BR + 3 * MiB, WO_UP = WO_O + 2 * MiB, WO_DN = WO_UP + 11 * MiB;
static_assert(WO_DN + (size_t)DM * DFF * 2 <= W_LAYER, "weight map");
constexpr size_t WS_HA = 75 * MiB;
constexpr size_t WS_YS = 107 * MiB;
constexpr size_t WS_HP = 107 * MiB;
constexpr int HP_ROWS = 1 + SEQ + 127;
constexpr size_t WS_R1 = 155 * MiB;
constexpr size_t WS_U = WS_R1, WS_DK = WS_R1 + 16 * MiB, WS_DV = WS_R1 + 32 * MiB, WS_SK = WS_R1 + 48 * MiB, WS_SV = WS_R1 + 52 * MiB;
constexpr size_t WS_GT = WS_R1;
constexpr size_t WS_ACT = WS_R1;
constexpr size_t WS_SCR = 211 * MiB;
constexpr size_t WS_END = 251 * MiB;
static_assert(WS_HP + (size_t)HP_ROWS * DM * 2 <= WS_R1 && WS_GT + (size_t)SEQ * NGATE * 2 <= WS_END && WS_SCR + 32 * MiB <= WS_END && WS_SV + 4 * MiB <= WS_SCR, "d_ws map");

constexpr int CW_BAR = 4096;
constexpr int RING_OFF = 0, RING_BYTES = 131072, XLDS_OFF = RING_BYTES, XLDS_BYTES = 8192, LDSCTL_OFF = XLDS_OFF + XLDS_BYTES, MISC_OFF = LDSCTL_OFF + 320;
constexpr int LDS_BYTES = 147456;
static_assert(MISC_OFF + 128 <= LDS_BYTES, "LDS map");

#define GAS __attribute__((address_space(1)))
#define LAS __attribute__((address_space(3)))
typedef unsigned short bf16;
typedef unsigned v4u __attribute__((ext_vector_type(4)));
typedef unsigned v2u __attribute__((ext_vector_type(2)));
typedef float f32x4 __attribute__((ext_vector_type(4)));
#define RLX_AGENT __ATOMIC_RELAXED, __HIP_MEMORY_SCOPE_AGENT
#define LDS_WAIT() asm volatile("s_waitcnt lgkmcnt(0)" ::: "memory")
#define VM_WAIT() asm volatile("s_waitcnt vmcnt(0)" ::: "memory")
__device__ __forceinline__ unsigned f2bf(float f) { unsigned u = __builtin_bit_cast(unsigned, f); return (u + 0x7fffu + ((u >> 16) & 1u)) >> 16; }
__device__ __forceinline__ unsigned pk2(float lo, float hi) { return f2bf(lo) | (f2bf(hi) << 16); }

#define XB_TMO      128
#define XB_XCNT(j)  (256  + 64 * (j))
#define XB_XSUB(j)  (1280 + 64 * (j))
#define XB_XGEN(j)  (2304 + 64 * (j))
#define XB_TOP      3328
#define XB_TOPGEN   3392
#define XCD_BAR_WORDS 3456
#define XB_SPIN_CAP (1u << 22)
__device__ __forceinline__ unsigned xb_ld(unsigned* p)              { return __hip_atomic_load(p, __ATOMIC_RELAXED, __HIP_MEMORY_SCOPE_AGENT); }
__device__ __forceinline__ unsigned xb_add(unsigned* p, unsigned v) { return __hip_atomic_fetch_add(p, v, __ATOMIC_RELAXED, __HIP_MEMORY_SCOPE_AGENT); }
__device__ __forceinline__ unsigned xb_xcc_id() { return (unsigned)__builtin_amdgcn_s_getreg((3 << 11) | 20) & 0xFu; }
#define XB_SPIN(cond, bar) do { unsigned _sp = 0; while (cond) { __builtin_amdgcn_s_sleep(1); \
    if ((++_sp & 255u) == 0u) { if (xb_ld(&(bar)[XB_TMO])) break; if (_sp > XB_SPIN_CAP) { atomicAdd(&(bar)[XB_TMO], 1u); break; } } } } while (0)
struct XcdBarrier { unsigned* bar; unsigned x; volatile LAS unsigned* st; };
__device__ __forceinline__ XcdBarrier xcd_barrier_post(unsigned* bar, volatile LAS unsigned* st) {
    XcdBarrier b; b.bar = bar; b.x = xb_xcc_id(); b.st = st;
    if (threadIdx.x == 0) (void)xb_add(&bar[XB_XCNT(b.x)], 1u);
    return b;
}
__device__ __forceinline__ void xcd_barrier_complete(unsigned* bar, unsigned x, unsigned& nloc, unsigned& nx) {
    const unsigned G = gridDim.x * gridDim.y * gridDim.z;
    unsigned sum, cnt, mine, sp = 0u;
    for (;;) {
        sum = 0u; cnt = 0u; mine = 0u;
#pragma unroll
        for (unsigned j = 0; j < 16; ++j) { const unsigned c = xb_ld(&bar[XB_XCNT(j)]); sum += c; cnt += (c > 0u) ? 1u : 0u; mine = (j == x) ? c : mine; }
        if (sum == G) break;
        __builtin_amdgcn_s_sleep(1);
        if ((++sp & 255u) == 0u) { if (xb_ld(&bar[XB_TMO])) break; if (sp > XB_SPIN_CAP) { atomicAdd(&bar[XB_TMO], 1u); break; } }
    }
    nloc = mine > 0u ? mine : 1u; nx = cnt > 0u ? cnt : 1u;
}
__device__ __forceinline__ void xcd_barrier(const XcdBarrier& b) {
    asm volatile("s_waitcnt vmcnt(0)" ::: "memory");
    __syncthreads();
    if (threadIdx.x == 0) {
        unsigned* bar = b.bar;
        __builtin_amdgcn_s_waitcnt(0);
        unsigned nloc = b.st[0], nx = b.st[1];
        if (nloc == 0u) { xcd_barrier_complete(bar, b.x, nloc, nx); b.st[0] = nloc; b.st[1] = nx; }
        const unsigned old = xb_add(&bar[XB_XSUB(b.x)], 1u);
        const unsigned gen = old / nloc;
        if (old + 1u == (gen + 1u) * nloc) {
            __builtin_amdgcn_fence(__ATOMIC_RELEASE, "agent");
            asm volatile("s_waitcnt vmcnt(0)" ::: "memory");
            const unsigned og = xb_add(&bar[XB_TOP], 1u);
            const unsigned tg = og / nx;
            if (og + 1u == (tg + 1u) * nx) xb_add(&bar[XB_TOPGEN], 1u);
            else XB_SPIN(xb_ld(&bar[XB_TOPGEN]) == tg, bar);
            __builtin_amdgcn_fence(__ATOMIC_ACQUIRE, "agent");
            xb_add(&bar[XB_XGEN(b.x)], 1u);
            asm volatile("s_waitcnt vmcnt(0)" ::: "memory");
        } else {
            XB_SPIN(xb_ld(&bar[XB_XGEN(b.x)]) == gen, bar);
            __builtin_amdgcn_fence(__ATOMIC_ACQUIRE, "agent");
            asm volatile("s_waitcnt vmcnt(0)" ::: "memory");
        }
    }
    __syncthreads();
}

__device__ __forceinline__ float wave_sum(float v) {
#pragma unroll
    for (int o = 1; o < 64; o <<= 1) v += __shfl_xor(v, o);
    return v;
}
__device__ __forceinline__ void conv_item(const float* W, int ldw, int k0, int srcc, bf16* WT, int ldt, int dstr, int dstk, LAS float* scr, int lane) {
#pragma unroll 8
    for (int i = 0; i < 32; ++i) { const int kk = 2 * i + (lane >> 5); scr[kk * 33 + (lane & 31)] = W[(size_t)(k0 + kk) * ldw + srcc + (lane & 31)]; }
    LDS_WAIT(); asm volatile("" ::: "memory");
    const int c = lane & 7;
#pragma unroll
    for (int j = 0; j < 4; ++j) { const int n = (lane >> 3) + 8 * j; const LAS float* s = scr + (8 * c) * 33 + n;
        v4u o; o.x = pk2(s[0 * 33], s[1 * 33]); o.y = pk2(s[2 * 33], s[3 * 33]); o.z = pk2(s[4 * 33], s[5 * 33]); o.w = pk2(s[6 * 33], s[7 * 33]);
        *(GAS v4u*)(WT + (size_t)(dstr + n) * ldt + dstk + 8 * c) = o; }
    LDS_WAIT(); asm volatile("" ::: "memory");
}
__device__ __forceinline__ int inmap(int gd) {
    const int tile = gd >> 3, bj = (gd >> 2) & 1, wc = gd & 3;
    if (tile < 4)  return (bj ? 1024 : 0) + 128 * tile + 32 * wc;
    if (tile < 6)  return 512 + 32 * (gd - 32);
    if (tile < 8)  return 1536 + (4 * (tile - 6) + wc) * 64 + 32 * bj;
    if (tile < 10) return 2048 + (4 * (tile - 8) + wc) * 64 + 32 * bj;
    if (tile < 12) return 2560 + 32 * (gd - 80);
    if (tile < 14) return 3072 + (4 * (tile - 12) + wc) * 64 + 32 * bj;
    return (wc < 2) ? 3584 + wc * 64 + 32 * bj : 3712 + 64 * bj + 32 * (wc - 2);
}
__device__ __forceinline__ int upmap(int gd) { const int tile = gd >> 3, bj = (gd >> 2) & 1, wc = gd & 3; return (bj ? DFF : 0) + 128 * tile + 32 * wc; }

__device__ __forceinline__ void ln_row(const float* src, const float* g, const float* b, float* dst32, bf16* dst16, int lane) {
    const f32x4* xr = (const f32x4*)src + lane;
    f32x4 v[4]; float s = 0.f;
#pragma unroll
    for (int j = 0; j < 4; ++j) { v[j] = xr[64 * j]; s += (v[j].x + v[j].y) + (v[j].z + v[j].w); }
    const float mean = wave_sum(s) * (1.f / DM); float s2 = 0.f;
#pragma unroll
    for (int j = 0; j < 4; ++j) { v[j] = v[j] - mean; s2 += (v[j].x * v[j].x + v[j].y * v[j].y) + (v[j].z * v[j].z + v[j].w * v[j].w); }
    const float rstd = 1.f / sqrtf(wave_sum(s2) * (1.f / DM) + LN_EPS);
#pragma unroll
    for (int j = 0; j < 4; ++j) { const f32x4 gg = ((const f32x4*)g)[lane + 64 * j], bb = ((const f32x4*)b)[lane + 64 * j];
        const f32x4 y = v[j] * rstd * gg + bb;
        ((f32x4*)dst32)[lane + 64 * j] = y;
        v2u w; w.x = pk2(y.x, y.y); w.y = pk2(y.z, y.w); ((v2u*)dst16)[lane + 64 * j] = w; }
}
__device__ __forceinline__ void sincos_d(double a, double& sn, double& cs) {
    const double q = __builtin_rint(a * 0.63661977236758134308);
    double r = __builtin_fma(-q, 1.57079632679489655800e+00, a); r = __builtin_fma(-q, 6.12323399573676603587e-17, r);
    const double r2 = r * r;
    double s = -7.6471637318198164759e-13; s = s * r2 + 1.6059043836821614599e-10; s = s * r2 - 2.5052108385441718775e-08; s = s * r2 + 2.7557319223985890653e-06;
    s = s * r2 - 1.9841269841269841270e-04; s = s * r2 + 8.3333333333333333333e-03; s = s * r2 - 1.6666666666666666667e-01; s = r + r * r2 * s;
    double c = 4.7794773323873852974e-14; c = c * r2 - 1.1470745597729724714e-11; c = c * r2 + 2.0876756987868098979e-09; c = c * r2 - 2.7557319223985890653e-07;
    c = c * r2 + 2.4801587301587301587e-05; c = c * r2 - 1.3888888888888888889e-03; c = c * r2 + 4.1666666666666666667e-02; c = c * r2 - 0.5; c = c * r2 + 1.0;
    const int qi = (int)((long long)q & 3);
    sn = (qi == 0) ? s : (qi == 1) ? c : (qi == 2) ? -s : -c;
    cs = (qi == 0) ? c : (qi == 1) ? -s : (qi == 2) ? -c : s;
}
__device__ __forceinline__ float rope_theta_pow(int i) {
    constexpr double T[32] = {1, 1.333521432163324, 1.7782794100389228, 2.3713737056616551, 3.1622776601683795, 4.2169650342858223, 5.6234132519034912, 7.4989420933245583, 10, 13.33521432163324,
        17.782794100389228, 23.713737056616552, 31.622776601683793, 42.169650342858226, 56.234132519034908, 74.989420933245583, 100, 133.35214321633239, 177.82794100389228, 237.13737056616552,
        316.22776601683796, 421.69650342858228, 562.34132519034904, 749.89420933245583, 1000, 1333.5214321633241, 1778.2794100389228, 2371.3737056616551, 3162.2776601683795, 4216.9650342858222,
        5623.4132519034911, 7498.9420933245583};
    return (float)T[i];
}

#ifndef MK_DIAG
#define MK_DIAG -1
#endif
#define PH_EN(k) ((MK_DIAG) < 0 || (MK_DIAG) == (k))
#ifndef ATT_SD
#define ATT_SD 1
#endif
struct Params { const float* in[20]; float* out; unsigned char* ws; int ph_lo, ph_hi, li, pad; };
enum { I_X = 0, I_POS, I_LNG, I_LNB, I_WIN, I_CONVW, I_DLAM, I_SUBG, I_SINK, I_WGATE, I_BGATE, I_WBR, I_WO, I_LMG, I_LMB, I_WUP, I_FCW, I_WDN, I_LFG, I_LFB };

template <int SUB>
__device__ __forceinline__ void run_phase(const int l, const int wave_s, LAS unsigned char* L, unsigned char* lds) {
        int lane_; asm volatile("v_mbcnt_lo_u32_b32 %0, -1, 0\n\tv_mbcnt_hi_u32_b32 %0, -1, %0" : "=v"(lane_));
        int bx = blockIdx.x, G = gridDim.x, wave = wave_s;
        asm volatile("" : "+s"(bx)); asm volatile("" : "+s"(G)); asm volatile("" : "+s"(wave));
        const int lane = lane_, tid = wave * 64 + lane_;
        const int vcu = (G % 8 == 0) ? (bx % 8) * (G / 8) + bx / 8 : bx;
        const int gw = vcu * NWAVES + wave, NGW = G * NWAVES;
        const __attribute__((address_space(4))) Params* pp = (const __attribute__((address_space(4))) Params*)__builtin_amdgcn_kernarg_segment_ptr();
        asm volatile("" : "+s"(pp));
#define PIN(i) (pp->in[i])
        unsigned char* ws = pp->ws;
        float* H32 = pp->out;
        float* COS = (float*)(ws + WS_COS); float* SIN = (float*)(ws + WS_SIN);
        bf16* HA = (bf16*)(ws + WS_HA); bf16* YS = (bf16*)(ws + WS_YS); bf16* HP = (bf16*)(ws + WS_HP);
        bf16* UB = (bf16*)(ws + WS_U); bf16* DKB = (bf16*)(ws + WS_DK); bf16* DVB = (bf16*)(ws + WS_DV); bf16* SKB = (bf16*)(ws + WS_SK); bf16* SVB = (bf16*)(ws + WS_SV);
        bf16* GT = (bf16*)(ws + WS_GT); bf16* ACT = (bf16*)(ws + WS_ACT); float* SCR = (float*)(ws + WS_SCR);
        unsigned char* wl = ws + WS_W + (size_t)l * W_LAYER;
        (void)lane; (void)gw; (void)NGW; (void)H32; (void)COS; (void)SIN; (void)HA; (void)YS; (void)HP; (void)UB; (void)DKB; (void)DVB; (void)SKB; (void)SVB; (void)GT; (void)ACT; (void)SCR; (void)wl; (void)vcu;
        if constexpr (SUB == -1) {
            LAS float* scr = (LAS float*)(L + RING_OFF + wave * 16384);
            constexpr int N_IN = 16 * 120, N_G = 16 * 96, N_BR = 3 * 8 * 32, N_O = 16 * 32, N_UP = 16 * 176, N_DN = 44 * 32, N_L = N_IN + N_G + N_BR + N_O + N_UP + N_DN;
            for (int it = gw; it < DEPTH * N_L; it += NGW) {
                const int ll = it / N_L; int r = it - ll * N_L; unsigned char* wb = ws + WS_W + (size_t)ll * W_LAYER;
                if (r < N_IN) { const int kb = r / 120, gd = r % 120; conv_item(PIN(I_WIN) + (size_t)ll * DM * DIN, DIN, kb * 64, inmap(gd), (bf16*)(wb + WO_IN), DM, gd * 32, kb * 64, scr, lane); continue; } r -= N_IN;
                if (r < N_G) { const int kb = r / 96, gd = r % 96; conv_item(PIN(I_WGATE) + (size_t)ll * DM * NGATE, NGATE, kb * 64, gd * 32, (bf16*)(wb + WO_G), DM, gd * 32, kb * 64, scr, lane); continue; } r -= N_G;
                if (r < N_BR) { const int n = r / 256, rr = r % 256, kb = rr / 32, gd = rr % 32; conv_item(PIN(I_WBR) + (size_t)(ll * 3 + n) * 512 * DM, DM, kb * 64, gd * 32, (bf16*)(wb + WO_BR), 1536, gd * 32, n * 512 + kb * 64, scr, lane); continue; } r -= N_BR;
                if (r < N_O) { const int kb = r / 32, gd = r % 32; conv_item(PIN(I_WO) + (size_t)ll * DM * DM, DM, kb * 64, gd * 32, (bf16*)(wb + WO_O), DM, gd * 32, kb * 64, scr, lane); continue; } r -= N_O;
                if (r < N_UP) { const int kb = r / 176, gd = r % 176; conv_item(PIN(I_WUP) + (size_t)ll * DM * NUP, NUP, kb * 64, upmap(gd), (bf16*)(wb + WO_UP), DM, gd * 32, kb * 64, scr, lane); continue; } r -= N_UP;
                { const int kb = r / 32, gd = r % 32; conv_item(PIN(I_WDN) + (size_t)ll * DFF * DM, DM, kb * 64, gd * 32, (bf16*)(wb + WO_DN), DFF, gd * 32, kb * 64, scr, lane); }
            }
            const int* pos = (const int*)PIN(I_POS);
            for (int idx = vcu * 512 + tid; idx < SEQ * 32; idx += G * 512) {
                const int t = idx >> 5, i = idx & 31;
                const float inv = 1.0f / rope_theta_pow(i);
                const float ang = (float)pos[t] * inv;
                double sd, cd; sincos_d((double)ang, sd, cd);
                COS[idx] = (float)cd; SIN[idx] = (float)sd;
            }
            for (int m = gw; m < SEQ; m += NGW) ln_row(PIN(I_X) + (size_t)m * DM, PIN(I_LNG), PIN(I_LNB), H32 + (size_t)m * DM, HA + (size_t)m * DM, lane);
        } else if constexpr (SUB == 0) {
            pg8::Gemm g{HA, (const bf16*)(wl + WO_IN), DM, DM, DM}; pg8::StaticOrder S; S.init(SEQ / 256, DIN / 256, G, bx, 256);
            pg8::EpiInProj E{UB, YS, DKB, DVB, SKB, SVB, COS, SIN};
            pg8::gemm_phase<pg8::EpiInProj, pg8::StaticOrder, true>(tid, L + RING_OFF, L + XLDS_OFF, g, S, E);
        } else if constexpr (SUB == 1) {
            char* al = (char*)lds;
            const int r32 = lane & 31, hi = lane >> 5;
            const float lambda_init = (l == 0) ? 0.2f : 0.35550906759096934f;
#ifndef MK_NO_DIFF
            for (int pair = vcu; pair < 256; pair += G) {
                const int h = pair >> 6, qb = pair & 63;
                const size_t qrow = (size_t)qb * 256 + wave * 32 + r32;
                f32x4* scr = (f32x4*)(SCR + ((size_t)(pair * 8 + wave) * 64 + lane) * 64);
                att::f32x16 o[4]; float lsum;
                att::attn_core<128, false, ATT_SD, 512, 512>(tid, YS + qrow * 1536 + 512 + h * 128 + hi * 8, DKB + h * 128, DVB + h * 128, SEQ / 64, -1e30f, 0.f, 0, 0, al, o, lsum);
                { const float rl = 1.0f / lsum;
#pragma unroll
                  for (int d = 0; d < 4; ++d)
#pragma unroll
                      for (int g4 = 0; g4 < 4; ++g4) scr[d * 4 + g4] = (f32x4){o[d][4 * g4] * rl, o[d][4 * g4 + 1] * rl, o[d][4 * g4 + 2] * rl, o[d][4 * g4 + 3] * rl}; }
                __syncthreads();
                att::attn_core<128, false, ATT_SD, 512, 512>(tid, YS + qrow * 1536 + 512 + h * 128 + 64 + hi * 8, DKB + h * 128 + 64, DVB + h * 128, SEQ / 64, -1e30f, 0.f, 0, 0, al, o, lsum);
                const float* lp = PIN(I_DLAM) + l * 256;
                const float s01 = wave_sum(lp[lane] * lp[64 + lane]), s23 = wave_sum(lp[128 + lane] * lp[192 + lane]);
                const float lam = __builtin_amdgcn_exp2f(s01 * 1.4426950408889634f) - __builtin_amdgcn_exp2f(s23 * 1.4426950408889634f) + lambda_init;
                const float rl1 = lam / lsum; float ss = 0.f;
                VM_WAIT();
#pragma unroll
                for (int d = 0; d < 4; ++d)
#pragma unroll
                    for (int g4 = 0; g4 < 4; ++g4) { const f32x4 sv = scr[d * 4 + g4];
#pragma unroll
                        for (int e = 0; e < 4; ++e) { const float y = sv[e] - o[d][4 * g4 + e] * rl1; o[d][4 * g4 + e] = y; ss += y * y; } }
                { auto rr = __builtin_amdgcn_permlane32_swap(__float_as_uint(ss), __float_as_uint(ss), false, false); ss = __uint_as_float(rr[0]) + __uint_as_float(rr[1]); }
                const float rms = (1.0f - lambda_init) / sqrtf(ss * (1.0f / 128.0f) + LN_EPS);
                const float* sg = PIN(I_SUBG) + l * 128;
                bf16* op = YS + qrow * 1536 + 512 + h * 128;
#pragma unroll
                for (int d = 0; d < 4; ++d)
#pragma unroll
                    for (int g4 = 0; g4 < 4; ++g4) { const int dc = 32 * d + 8 * g4 + 4 * hi; const f32x4 gg = *(const f32x4*)(sg + dc);
                        v2u w; w.x = pk2(o[d][4 * g4] * rms * gg.x, o[d][4 * g4 + 1] * rms * gg.y); w.y = pk2(o[d][4 * g4 + 2] * rms * gg.z, o[d][4 * g4 + 3] * rms * gg.w);
                        *(v2u*)(op + dc) = w; }
                __syncthreads();
            }
#endif
#ifndef MK_NO_SWA
            for (int su = vcu; su < 512; su += G) {
                const int hq = su >> 6, qb = su & 63, q0 = qb * 256, kvh = hq >> 2;
                const int ks = (q0 - 128 < 0) ? 0 : q0 - 128, ke = (q0 + 384 > SEQ) ? SEQ : q0 + 384, NT = (ke - ks) / 64;
                const int qpos = q0 + wave * 32 + r32;
                att::f32x16 o[2]; float lsum;
                att::attn_core<64, true, 2, 128, 128>(tid, YS + (size_t)qpos * 1536 + 1024 + hq * 64 + hi * 8, SKB + (size_t)ks * 128 + kvh * 64, SVB + (size_t)ks * 128 + kvh * 64, NT,
                                         PIN(I_SINK)[l * 8 + hq] * 8.0f, 1.0f, ks - qpos, 128, al, o, lsum);
                const float rl = 1.0f / lsum;
                bf16* op = YS + (size_t)qpos * 1536 + 1024 + hq * 64;
#pragma unroll
                for (int d = 0; d < 2; ++d)
#pragma unroll
                    for (int g4 = 0; g4 < 4; ++g4) { const int dc = 32 * d + 8 * g4 + 4 * hi;
                        v2u w; w.x = pk2(o[d][4 * g4] * rl, o[d][4 * g4 + 1] * rl); w.y = pk2(o[d][4 * g4 + 2] * rl, o[d][4 * g4 + 3] * rl);
                        *(v2u*)(op + dc) = w; }
                __syncthreads();
            }
#endif
            const float* cw = PIN(I_CONVW) + l * 3 * 512;
            for (int idx = vcu * 512 + tid; idx < SEQ * 64; idx += G * 512) {
                const int t = idx >> 6, c8 = (idx & 63) * 8;
                const v4u z = {0u, 0u, 0u, 0u};
                const v4u uc = *(const v4u*)(UB + (size_t)t * 512 + c8);
                const v4u up = (t > 0) ? *(const v4u*)(UB + (size_t)(t - 1) * 512 + c8) : z;
                const v4u un = (t < SEQ - 1) ? *(const v4u*)(UB + (size_t)(t + 1) * 512 + c8) : z;
                const v4u ab = *(const v4u*)(YS + (size_t)t * 1536 + c8);
                f32x4 ca, cb, pa, pb, na, nb, ba, bb; pg8::unpack8(uc, ca, cb); pg8::unpack8(up, pa, pb); pg8::unpack8(un, na, nb); pg8::unpack8(ab, ba, bb);
                const f32x4 w0a = *(const f32x4*)(cw + c8), w0b = *(const f32x4*)(cw + c8 + 4), w1a = *(const f32x4*)(cw + 512 + c8), w1b = *(const f32x4*)(cw + 512 + c8 + 4);
                const f32x4 w2a = *(const f32x4*)(cw + 1024 + c8), w2b = *(const f32x4*)(cw + 1024 + c8 + 4);
                const f32x4 ya = ba * (w0a * pa + w1a * ca + w2a * na), yb = bb * (w0b * pb + w1b * cb + w2b * nb);
                *(v4u*)(YS + (size_t)t * 1536 + c8) = pg8::pack8(ya, yb);
            }
        } else if constexpr (SUB == 2) {
            pg8::Gemm g{HA, (const bf16*)(wl + WO_G), DM, DM, DM}; pg8::StaticOrder S; S.init(SEQ / 256, NGATE / 256, G, bx, 256);
            pg8::EpiGates E{GT, PIN(I_BGATE) + l * NGATE};
            pg8::gemm_phase<pg8::EpiGates, pg8::StaticOrder, true>(tid, L + RING_OFF, L + XLDS_OFF, g, S, E);
        } else if constexpr (SUB == 3) {
            pg8::Gemm g{YS, (const bf16*)(wl + WO_BR), 1536, 1536, 512}; pg8::SegOrder S; S.init(SEQ / 256, DM / 256, G, bx, 3, 512);
            pg8::EpiBranch E{HA, GT};
            pg8::gemm_phase<pg8::EpiBranch, pg8::SegOrder, true>(tid, L + RING_OFF, L + XLDS_OFF, g, S, E);
        } else if constexpr (SUB == 4 || SUB == 7) {
            pg8::Gemm g{(SUB == 4) ? HA : ACT, (const bf16*)(wl + ((SUB == 4) ? WO_O : WO_DN)), (SUB == 4) ? DM : DFF, (SUB == 4) ? DM : DFF, (SUB == 4) ? DM : DFF};
            pg8::StaticOrder S; S.init(SEQ / 256, DM / 256, G, bx, 256);
            pg8::EpiResid E{H32, ALPHA};
            pg8::gemm_phase<pg8::EpiResid, pg8::StaticOrder, true>(tid, L + RING_OFF, L + XLDS_OFF, g, S, E);
        } else if constexpr (SUB == 5 || SUB == 8) {
            const float* gg = PIN((SUB == 5) ? I_LMG : I_LFG) + l * DM; const float* bb = PIN((SUB == 5) ? I_LMB : I_LFB) + l * DM;
            bf16* dst = (SUB == 5) ? HP + DM : HA;
            for (int m = gw; m < SEQ; m += NGW) ln_row(H32 + (size_t)m * DM, gg, bb, H32 + (size_t)m * DM, dst + (size_t)m * DM, lane);
            if (SUB == 5) {
                for (int idx = vcu * 512 + tid; idx < 128 * (DM / 8); idx += G * 512) { const int rr = idx / (DM / 8), c8 = (idx % (DM / 8)) * 8; const int row = (rr == 0) ? 0 : SEQ + rr;
                    *(v4u*)(HP + (size_t)row * DM + c8) = (v4u){0u, 0u, 0u, 0u}; }
            }
        } else if constexpr (SUB == 9) {
#ifdef MK_DUMP
            for (int idx = vcu * 512 + tid; idx < SEQ * 128; idx += G * 512) {
                const int t = idx >> 7, c8 = (idx & 127) * 8;
                const bf16* src;
                if (MK_DUMP == 1) src = YS + (size_t)t * 1536 + c8;
                else if (MK_DUMP == 2) src = YS + (size_t)t * 1536 + 512 + c8;
                else if (MK_DUMP == 3) src = UB + (size_t)t * 512 + (c8 & 511);
                else if (MK_DUMP == 4) src = (c8 < 512) ? DKB + (size_t)t * 512 + c8 : DVB + (size_t)t * 512 + (c8 - 512);
                else if (MK_DUMP == 5) src = (c8 < 512) ? SKB + (size_t)t * 128 + (c8 & 127) : SVB + (size_t)t * 128 + (c8 & 127);
                else if (MK_DUMP == 6) src = GT + (size_t)t * 3072 + c8;
                else if (MK_DUMP == 7) src = GT + (size_t)t * 3072 + 1024 + c8;
                else if (MK_DUMP == 8) src = GT + (size_t)t * 3072 + 2048 + c8;
                else src = HA + (size_t)t * 1024 + c8;
                const v4u w = *(const v4u*)src; f32x4 a, b; pg8::unpack8(w, a, b);
                *(f32x4*)(H32 + (size_t)t * 1024 + c8) = a; *(f32x4*)(H32 + (size_t)t * 1024 + c8 + 4) = b;
            }
#endif
        } else if constexpr (SUB == 6) {
            pg8::Gemm g{HP, (const bf16*)(wl + WO_UP), DM, DM, DM}; pg8::StaticOrder S; S.init(65, NUP / 256, G, bx, 254);
            pg8::EpiUpConv E{ACT, PIN(I_FCW) + (size_t)l * 3 * NUP};
            pg8::gemm_phase<pg8::EpiUpConv, pg8::StaticOrder, true>(tid, L + RING_OFF, L + XLDS_OFF, g, S, E);
        }
#undef PIN
}

__global__ void __launch_bounds__(NWAVES * 64, 2) mk_fwd(Params p) {
    extern __shared__ __attribute__((aligned(16))) unsigned char lds[];
    LAS unsigned char* L = (LAS unsigned char*)lds;
    volatile LAS unsigned* MISC = (volatile LAS unsigned*)(L + MISC_OFF);
    for (int u = threadIdx.x; u < (LDS_BYTES - LDSCTL_OFF) / 4; u += NWAVES * 64) ((LAS unsigned*)(L + LDSCTL_OFF))[u] = 0u;
    __syncthreads();
    const int wave_s = __builtin_amdgcn_readfirstlane((int)threadIdx.x >> 6);
#if MK_ONE_LAUNCH
    (void)xcd_barrier_post((unsigned*)(p.ws + WS_CTL) + CW_BAR, MISC + 8);
#define GRID_BAR() do { XcdBarrier bar_; bar_.bar = (unsigned*)(((const __attribute__((address_space(4))) Params*)__builtin_amdgcn_kernarg_segment_ptr())->ws + WS_CTL) + CW_BAR; bar_.x = xb_xcc_id(); bar_.st = MISC + 8; xcd_barrier(bar_); } while (0)
    constexpr int lo = 0, hi = NPHASE;
#else
    (void)MISC;
#define GRID_BAR() do {} while (0)
    const int lo = p.ph_lo, hi = p.ph_hi;
#endif
#define PH(k, SUBV, lv) if (PH_EN(k) && lo <= (k) && (k) < hi) { run_phase<SUBV>(lv, wave_s, L, lds); if ((k) + 1 < hi) GRID_BAR(); }
    PH(0, -1, 0)
    PH(1, 0, 0) PH(2, 1, 0) PH(3, 2, 0) PH(4, 3, 0) PH(5, 4, 0) PH(6, 5, 0) PH(7, 6, 0) PH(8, 7, 0) PH(9, 8, 0)
    PH(10, 0, 1) PH(11, 1, 1) PH(12, 2, 1) PH(13, 3, 1) PH(14, 4, 1) PH(15, 5, 1) PH(16, 6, 1) PH(17, 7, 1) PH(18, 8, 1)
#ifdef MK_DUMP
    PH(19, 9, 0)
#endif
#undef PH
}

extern "C" void kernel_launch(void* const* d_in, const int* in_sizes, int n_in, void* d_out, int out_size, void* d_ws, size_t ws_size, hipStream_t stream) {
    static int grid = 0;
    if (grid == 0) {
        if (n_in != 20 || in_sizes[0] != SEQ * DM || out_size != SEQ * DM || ws_size < WS_END) { fprintf(stderr, "kernel_launch: shape/workspace mismatch n_in %d in0 %d out %d ws %zu (need %zu)\n", n_in, n_in > 0 ? in_sizes[0] : -1, out_size, ws_size, (size_t)WS_END); grid = -1; return; }
        int dev = 0, cus = 0, per_cu = 0;
        if (hipGetDevice(&dev) != hipSuccess || hipDeviceGetAttribute(&cus, hipDeviceAttributeMultiprocessorCount, dev) != hipSuccess) { grid = -1; return; }
        if (hipFuncSetAttribute((const void*)mk_fwd, hipFuncAttributeMaxDynamicSharedMemorySize, LDS_BYTES) != hipSuccess) { fprintf(stderr, "kernel_launch: hipFuncSetAttribute failed\n"); grid = -1; return; }
        if (hipOccupancyMaxActiveBlocksPerMultiprocessor(&per_cu, (const void*)mk_fwd, NWAVES * 64, LDS_BYTES) != hipSuccess || per_cu < 1) { fprintf(stderr, "kernel_launch: occupancy query says %d blocks per CU\n", per_cu); (void)hipGetLastError(); grid = -1; return; }
        grid = cus;
    }
    if (grid < 0) return;
    if (hipMemsetAsync((char*)d_ws + WS_CTL, 0, CTL_ZERO_BYTES, stream) != hipSuccess) return;
    Params a{};
    for (int i = 0; i < 20; ++i) a.in[i] = (const float*)d_in[i];
    a.out = (float*)d_out; a.ws = (unsigned char*)d_ws; a.li = 0; a.pad = 0;
#if MK_ONE_LAUNCH
    a.ph_lo = 0; a.ph_hi = NPHASE;
    hipLaunchKernelGGL(mk_fwd, dim3(grid), dim3(NWAVES * 64), LDS_BYTES, stream, a);
#else
#ifdef MK_PHLIST
    { const int phl[] = MK_PHLIST; for (int i = 0; i < (int)(sizeof(phl) / sizeof(int)); ++i) { a.ph_lo = phl[i]; a.ph_hi = phl[i] + 1; hipLaunchKernelGGL(mk_fwd, dim3(grid), dim3(NWAVES * 64), LDS_BYTES, stream, a); } }
#else
    for (int ph = 0; ph < NPHASE; ++ph) { a.ph_lo = ph; a.ph_hi = ph + 1; hipLaunchKernelGGL(mk_fwd, dim3(grid), dim3(NWAVES * 64), LDS_BYTES, stream, a); }
#endif
#endif
    const hipError_t le = hipPeekAtLastError();
    if (le != hipSuccess) fprintf(stderr, "kernel_launch: launch failed: %s\n", hipGetErrorName(le));
}
```

```cpp
#include <hip/hip_runtime.h>
#include <hip/hip_bf16.h>
#include <cstdio>
#include <cstdint>

#ifndef MK_ONE_LAUNCH
#define MK_ONE_LAUNCH 1
#endif

namespace pg8 {
#define PG8_LAS __attribute__((address_space(3)))
typedef unsigned short bf16_t;
typedef short bf16x8 __attribute__((ext_vector_type(8)));
typedef float f32x4 __attribute__((ext_vector_type(4)));
typedef float f32x2 __attribute__((ext_vector_type(2)));
typedef unsigned u32x4 __attribute__((ext_vector_type(4)));
typedef unsigned u32x2 __attribute__((ext_vector_type(2)));
constexpr int BM = 256, BK = 64, HALF = 128, HTB = HALF * BK * 2  , STAGE_BYTES = 8 * HTB, NXCD = 8, WGM = 8;

__host__ __device__ __forceinline__ int lds_byte(int r, int c) { const int st = (r >> 4) * 2 + (c >> 5), rr = r & 15, cc = c & 31, ob = rr * 64 + cc * 2; return st * 1024 + (ob ^ (((ob >> 9) & 1) << 5)); }
__host__ __device__ __forceinline__ void stage_rc(int b, int& R, int& C) { const int st = b / 1024, sb = b % 1024, swz = sb ^ (((sb >> 9) & 1) << 5); R = (st >> 1) * 16 + swz / 64; C = (st & 1) * 32 + (swz % 64) / 2; }
__host__ __device__ __forceinline__ int perm32(int rho) { const int n = rho >> 4, i = rho & 15; return 8 * (i >> 2) + 4 * n + (i & 3); }

struct Unit { int pm, pn, arow, brow, kofs, seg; };
struct Gemm { const bf16_t* A; const bf16_t* Bt; int lda, ldb, K; };

struct StaticOrder {
    int nM, nN, nwg, G, c, rowstep;
    __device__ void init(int nM_, int nN_, int G_, int c_, int rowstep_) { nM = nM_; nN = nN_; nwg = nM * nN; G = G_; c = c_; rowstep = rowstep_; }
    __device__ bool next(int i, Unit& u) const {
        const long L = (long)i * G + c; if (L >= nwg) return false;
        int wgid = (int)L; { const int q = nwg / NXCD, r = nwg % NXCD, xcd = wgid % NXCD, off = wgid / NXCD; wgid = (xcd < r ? xcd * (q + 1) : r * (q + 1) + (xcd - r) * q) + off; }
        const int nig = WGM * nN, gid = wgid / nig, fm = gid * WGM, gsz = (nM - fm) < WGM ? (nM - fm) : WGM;
        u.pm = fm + ((wgid % nig) % gsz); u.pn = (wgid % nig) / gsz; u.arow = u.pm * rowstep; u.brow = u.pn * BM; u.kofs = 0; u.seg = 0; return true;
    }
};
struct SegOrder {
    StaticOrder so; int nseg, klen;
    __device__ void init(int nM_, int nN_, int G_, int c_, int nseg_, int klen_) { so.init(nM_, nN_, G_, c_, BM); nseg = nseg_; klen = klen_; }
    __device__ bool next(int i, Unit& u) const { const int t = i / nseg, s = i - t * nseg; if (!so.next(t, u)) return false; u.kofs = s * klen; u.seg = s; return true; }
};

typedef __bf16 bf16x2_t __attribute__((ext_vector_type(2)));
__device__ __forceinline__ unsigned cvt_pk_bf16(float lo, float hi) { f32x2 v = {lo, hi}; bf16x2_t b = __builtin_convertvector(v, bf16x2_t); return __builtin_bit_cast(unsigned, b); }
__device__ __forceinline__ float bf_lo(unsigned w) { return __uint_as_float(w << 16); }
__device__ __forceinline__ float bf_hi(unsigned w) { return __uint_as_float(w & 0xffff0000u); }
__device__ __forceinline__ u32x4 pack8(const f32x4 a, const f32x4 b) { u32x4 w; w.x = cvt_pk_bf16(a[0], a[1]); w.y = cvt_pk_bf16(a[2], a[3]); w.z = cvt_pk_bf16(b[0], b[1]); w.w = cvt_pk_bf16(b[2], b[3]); return w; }
__device__ __forceinline__ void unpack8(const u32x4 w, f32x4& a, f32x4& b) { a = (f32x4){bf_lo(w.x), bf_hi(w.x), bf_lo(w.y), bf_hi(w.y)}; b = (f32x4){bf_lo(w.z), bf_hi(w.z), bf_lo(w.w), bf_hi(w.w)}; }
__device__ __forceinline__ f32x2 gelu_pk(f32x2 v) {
    const f32x2 av = __builtin_elementwise_abs(v), d = av * 0.2316418882f + 1.0f;
    f32x2 t; t.x = __builtin_amdgcn_rcpf(d.x); t.y = __builtin_amdgcn_rcpf(d.y);
    f32x2 q = t * 0.5307027145f + (-0.7265760135f); q = q * t + 0.7107068705f; q = q * t + (-0.142248368f); q = q * t + 0.127414796f; q = q * t;
    const f32x2 s = (v * v) * (-0.72134752044f);
    f32x2 e; e.x = __builtin_amdgcn_exp2f(s.x); e.y = __builtin_amdgcn_exp2f(s.y);
    const f32x2 m = v * (q * e), r = v - m;
    f32x2 o; o.x = v.x < 0.f ? m.x : r.x; o.y = v.y < 0.f ? m.y : r.y; return o;
}
__device__ __forceinline__ f32x4 gelu4(f32x4 v) { f32x2 a = gelu_pk((f32x2){v[0], v[1]}), b = gelu_pk((f32x2){v[2], v[3]}); return (f32x4){a.x, a.y, b.x, b.y}; }

template <class Epi, class Sched, bool ALIGN_EPI>
__device__ __forceinline__ void gemm_phase(const int tid, PG8_LAS unsigned char* lds, PG8_LAS unsigned char* xlds, const Gemm g, const Sched& S, const Epi& E) {
    const int wid = __builtin_amdgcn_readfirstlane(tid >> 6), lane = tid & 63, wr = wid >> 2, wc = wid & 3, fr = lane & 15, fq = lane >> 4;
    const int K = g.K, nt = K / BK;
    unsigned voffA[2], voffB[2];
#pragma unroll
    for (int i = 0; i < 2; ++i) { int R, C; stage_rc(tid * 16 + i * 8192, R, C); const int Rb = Epi::PERM ? ((R & ~31) + perm32(R & 31)) : R;
        voffA[i] = (unsigned)(R * g.lda + C) * 2u; voffB[i] = (unsigned)(Rb * g.ldb + C) * 2u; }
    const size_t kstep = (size_t)(BK * 2);
    const size_t hstepA = (size_t)HALF * g.lda * 2, hstepB = (size_t)HALF * g.ldb * 2;
    const unsigned ldsw = (unsigned)wid * 1024u;
    const int aoff = lds_byte(wr * 64 + fr, fq * 8), boff = lds_byte(wc * 32 + fr, fq * 8);
#define PG8_SA(b, h) (((b) * 2 + (h)) * HTB)
#define PG8_SB(b, h) ((4 + (b) * 2 + (h)) * HTB)
#define PG8_STAGE(bufoff, gbase, voff) do { _Pragma("unroll") for (int _i = 0; _i < 2; ++_i) \
        __builtin_amdgcn_global_load_lds((const unsigned*)((const char*)(gbase) + (voff)[_i]), (PG8_LAS unsigned*)(lds + (bufoff) + ldsw + _i * 8192), 16, 0, 0); } while (0)
#define PG8_LDA(dst, b, h) do { _Pragma("unroll") for (int m = 0; m < 4; ++m) _Pragma("unroll") for (int k = 0; k < 2; ++k) dst[m][k] = *(const PG8_LAS bf16x8*)(lds + PG8_SA(b, h) + aoff + m * 2048 + k * 1024); } while (0)
#define PG8_LDB(dst, b, h) do { _Pragma("unroll") for (int n = 0; n < 2; ++n) _Pragma("unroll") for (int k = 0; k < 2; ++k) dst[n][k] = *(const PG8_LAS bf16x8*)(lds + PG8_SB(b, h) + boff + n * 2048 + k * 1024); } while (0)
#define PG8_MMA(ai, bj, At, Bt) do { __builtin_amdgcn_s_setprio(1); _Pragma("unroll") for (int m = 0; m < 4; ++m) _Pragma("unroll") for (int n = 0; n < 2; ++n) _Pragma("unroll") for (int k = 0; k < 2; ++k) \
        acc[ai][bj][m][n] = __builtin_amdgcn_mfma_f32_16x16x32_bf16(Bt[n][k], At[m][k], acc[ai][bj][m][n], 0, 0, 0); __builtin_amdgcn_s_setprio(0); } while (0)
#define PG8_WAIT_V(n) asm volatile("s_waitcnt vmcnt(" #n ")" ::: "memory")
#define PG8_WAIT_L(n) asm volatile("s_waitcnt lgkmcnt(" #n ")" ::: "memory")
#define PG8_BAR __builtin_amdgcn_s_barrier()
#define PG8_SCHED __builtin_amdgcn_sched_barrier(0)
    Unit cur, nxt; int ui = 0;
    if (!S.next(0, cur)) return;
    f32x4 acc[2][2][4][2];
#pragma unroll
    for (int a = 0; a < 2; ++a)
#pragma unroll
        for (int b = 0; b < 2; ++b)
#pragma unroll
            for (int m = 0; m < 4; ++m)
#pragma unroll
                for (int n = 0; n < 2; ++n) acc[a][b][m][n] = (f32x4){0.f, 0.f, 0.f, 0.f};
    bf16x8 At[4][2], B0[2][2], B1[2][2];
    const char* cA = (const char*)g.A + ((size_t)cur.arow * g.lda + cur.kofs) * 2; const char* cB = (const char*)g.Bt + ((size_t)cur.brow * g.ldb + cur.kofs) * 2;
    PG8_STAGE(PG8_SB(0, 0), cB, voffB); PG8_STAGE(PG8_SB(0, 1), cB + hstepB, voffB); PG8_STAGE(PG8_SA(0, 0), cA, voffA); PG8_STAGE(PG8_SA(0, 1), cA + hstepA, voffA);
    if (wr == 1) PG8_BAR;
    PG8_WAIT_V(2); PG8_BAR;
    PG8_STAGE(PG8_SB(1, 0), cB + kstep, voffB); PG8_STAGE(PG8_SA(1, 0), cA + kstep, voffA); PG8_STAGE(PG8_SB(1, 1), cB + hstepB + kstep, voffB);
    PG8_WAIT_V(6); PG8_BAR;
    for (;;) {
        const bool has_next = S.next(ui + 1, nxt);
        const char* nA = has_next ? (const char*)g.A + ((size_t)nxt.arow * g.lda + nxt.kofs) * 2 : cA; const char* nB = has_next ? (const char*)g.Bt + ((size_t)nxt.brow * g.ldb + nxt.kofs) * 2 : cB;
        for (int t = 0; t < nt; t += 2) {
            const bool last = (t == nt - 2);
            const char* a1 = cA + (size_t)(t + 1) * kstep;
            const char* a2 = last ? nA : cA + (size_t)(t + 2) * kstep; const char* b2 = last ? nB : cB + (size_t)(t + 2) * kstep;
            const char* a3 = a2 + kstep; const char* b3 = b2 + kstep;
            PG8_LDB(B0, 0, 0); PG8_LDB(B1, 0, 1); PG8_SCHED; PG8_LDA(At, 0, 0); PG8_STAGE(PG8_SA(1, 1), a1 + hstepA, voffA);
            PG8_WAIT_V(8); PG8_WAIT_L(0); PG8_BAR; PG8_MMA(0, 0, At, B0); PG8_MMA(0, 1, At, B1); PG8_BAR; PG8_SCHED;
            PG8_LDA(At, 0, 1); PG8_STAGE(PG8_SB(0, 0), b2, voffB); PG8_STAGE(PG8_SB(0, 1), b2 + hstepB, voffB); PG8_STAGE(PG8_SA(0, 0), a2, voffA);
            PG8_WAIT_V(8); PG8_WAIT_L(0); PG8_BAR; PG8_MMA(1, 0, At, B0); PG8_MMA(1, 1, At, B1); PG8_BAR; PG8_SCHED;
            PG8_LDB(B0, 1, 0); PG8_LDB(B1, 1, 1); PG8_SCHED; PG8_LDA(At, 1, 0); PG8_STAGE(PG8_SA(0, 1), a2 + hstepA, voffA);
            PG8_WAIT_V(8); PG8_WAIT_L(0); PG8_BAR; PG8_MMA(0, 0, At, B0); PG8_MMA(0, 1, At, B1); PG8_BAR; PG8_SCHED;
            PG8_LDA(At, 1, 1); PG8_STAGE(PG8_SB(1, 0), b3, voffB); PG8_STAGE(PG8_SB(1, 1), b3 + hstepB, voffB); PG8_STAGE(PG8_SA(1, 0), a3, voffA);
            PG8_WAIT_V(8); PG8_WAIT_L(0); PG8_BAR; PG8_MMA(1, 0, At, B0); PG8_MMA(1, 1, At, B1); PG8_BAR; PG8_SCHED;
        }
        if constexpr (ALIGN_EPI) { if (wr == 0) PG8_BAR; }
        if constexpr (!Epi::AFTER_DRAIN) { E(acc, cur, wr, wc, fr, fq, xlds, wid, lane); }
        if (!has_next) break;
#pragma unroll
        for (int a = 0; a < 2; ++a)
#pragma unroll
            for (int b = 0; b < 2; ++b)
#pragma unroll
                for (int m = 0; m < 4; ++m)
#pragma unroll
                    for (int n = 0; n < 2; ++n) acc[a][b][m][n] = (f32x4){0.f, 0.f, 0.f, 0.f};
        cur = nxt; cA = nA; cB = nB; ++ui;
        if constexpr (ALIGN_EPI) { if (wr == 1) PG8_BAR; }
    }
    PG8_WAIT_V(0);
    if constexpr (!ALIGN_EPI) { if (wr == 0) PG8_BAR; }
    PG8_BAR;
    if constexpr (Epi::AFTER_DRAIN) { E.fused(acc, cur, wr, wc, fr, fq, lds, wid, lane); }
#undef PG8_SA
#undef PG8_SB
#undef PG8_STAGE
#undef PG8_LDA
#undef PG8_LDB
#undef PG8_MMA
#undef PG8_WAIT_V
#undef PG8_WAIT_L
#undef PG8_BAR
#undef PG8_SCHED
}

typedef const f32x4 (&AccRef)[2][2][4][2];
#define PG8_EPI_ARGS AccRef acc, const Unit& u, int wr, int wc, int fr, int fq, PG8_LAS unsigned char* xlds, int wid, int lane

struct EpiInProj {
    static constexpr bool PERM = true, AFTER_DRAIN = false;
    bf16_t *U, *YS, *DK, *DV, *SK, *SV; const float *cs, *sn;
    __device__ __forceinline__ void operator()(PG8_EPI_ARGS) const {
        const int pn = u.pn, row0 = u.pm * BM + wr * 64 + fr;
        int kind, ld, d0, d1; bf16_t* base;
        if (pn < 4)       { kind = 0; base = U;  ld = 512;  d0 = 128 * pn + 32 * wc + 8 * fq; d1 = 0; }
        else if (pn < 6)  { kind = 1; base = YS; ld = 1536; d0 = (pn - 4) * 256 + 32 * wc + 8 * fq; d1 = d0 + 128; }
        else if (pn < 8)  { kind = 2; base = YS; ld = 1536; d0 = 512 + (4 * (pn - 6) + wc) * 64 + 8 * fq; d1 = d0 + 32; }
        else if (pn < 10) { kind = 2; base = DK; ld = 512;  d0 = (4 * (pn - 8) + wc) * 64 + 8 * fq; d1 = d0 + 32; }
        else if (pn < 12) { kind = 1; base = DV; ld = 512;  d0 = (pn - 10) * 256 + 32 * wc + 8 * fq; d1 = d0 + 128; }
        else if (pn < 14) { kind = 2; base = YS; ld = 1536; d0 = 1024 + (4 * (pn - 12) + wc) * 64 + 8 * fq; d1 = d0 + 32; }
        else if (wc < 2)  { kind = 2; base = SK; ld = 128;  d0 = wc * 64 + 8 * fq; d1 = d0 + 32; }
        else              { kind = 1; base = SV; ld = 128;  d0 = 32 * (wc - 2) + 8 * fq; d1 = d0 + 64; }
#pragma unroll
        for (int ai = 0; ai < 2; ++ai)
#pragma unroll
            for (int m = 0; m < 4; ++m) {
                const int row = row0 + ai * HALF + m * 16;
                bf16_t* rp = base + (size_t)row * ld;
                const f32x4 x0a = acc[ai][0][m][0], x0b = acc[ai][0][m][1], x1a = acc[ai][1][m][0], x1b = acc[ai][1][m][1];
                if (kind == 0) { *(u32x4*)(rp + d0) = pack8(x0a * x1a, x0b * x1b); }
                else if (kind == 1) { *(u32x4*)(rp + d0) = pack8(x0a, x0b); *(u32x4*)(rp + d1) = pack8(x1a, x1b); }
                else {
                    const f32x4 ca = *(const f32x4*)(cs + (size_t)row * 32 + 8 * fq), cb = *(const f32x4*)(cs + (size_t)row * 32 + 8 * fq + 4);
                    const f32x4 sa = *(const f32x4*)(sn + (size_t)row * 32 + 8 * fq), sb = *(const f32x4*)(sn + (size_t)row * 32 + 8 * fq + 4);
                    *(u32x4*)(rp + d0) = pack8(x0a * ca - x1a * sa, x0b * cb - x1b * sb);
                    *(u32x4*)(rp + d1) = pack8(x1a * ca + x0a * sa, x1b * cb + x0b * sb);
                }
            }
    }
};

struct EpiGates {
    static constexpr bool PERM = true, AFTER_DRAIN = false;
    bf16_t* G; const float* bias;
    __device__ __forceinline__ void operator()(PG8_EPI_ARGS) const {
        const int row0 = u.pm * BM + wr * 64 + fr, col0 = u.pn * BM + wc * 32 + 8 * fq;
        f32x4 bv[2][2];
#pragma unroll
        for (int bj = 0; bj < 2; ++bj)
#pragma unroll
            for (int n = 0; n < 2; ++n) bv[bj][n] = *(const f32x4*)(bias + col0 + bj * HALF + 4 * n);
#pragma unroll
        for (int ai = 0; ai < 2; ++ai)
#pragma unroll
            for (int m = 0; m < 4; ++m) { bf16_t* rp = G + (size_t)(row0 + ai * HALF + m * 16) * 3072 + col0;
#pragma unroll
                for (int bj = 0; bj < 2; ++bj) { f32x4 v[2];
#pragma unroll
                    for (int n = 0; n < 2; ++n) { const f32x4 x = acc[ai][bj][m][n] + bv[bj][n];
#pragma unroll
                        for (int e = 0; e < 4; ++e) v[n][e] = __builtin_amdgcn_rcpf(1.0f + __builtin_amdgcn_exp2f(x[e] * -1.4426950408889634f)); }
                    *(u32x4*)(rp + bj * HALF) = pack8(v[0], v[1]); } }
    }
};

struct EpiBranch {
    static constexpr bool PERM = true, AFTER_DRAIN = false;
    bf16_t* O; const bf16_t* GT;
    __device__ __forceinline__ void operator()(PG8_EPI_ARGS) const {
        const int row0 = u.pm * BM + wr * 64 + fr, col0 = u.pn * BM + wc * 32 + 8 * fq, seg = u.seg;
#pragma unroll
        for (int ai = 0; ai < 2; ++ai)
#pragma unroll
            for (int m = 0; m < 4; ++m) { const int row = row0 + ai * HALF + m * 16;
#pragma unroll
                for (int bj = 0; bj < 2; ++bj) {
                    const u32x4 gw = *(const u32x4*)(GT + (size_t)row * 3072 + seg * 1024 + col0 + bj * HALF);
                    f32x4 ga, gb; unpack8(gw, ga, gb);
                    f32x4 va = ga * acc[ai][bj][m][0], vb = gb * acc[ai][bj][m][1];
                    bf16_t* op = O + (size_t)row * 1024 + col0 + bj * HALF;
                    if (seg > 0) { const u32x4 pw = *(const u32x4*)op; f32x4 pa, pb; unpack8(pw, pa, pb); va += pa; vb += pb; }
                    *(u32x4*)op = pack8(va, vb); } }
    }
};

struct EpiResid {
    static constexpr bool PERM = true, AFTER_DRAIN = false;
    float* H; float alpha;
    __device__ __forceinline__ void operator()(PG8_EPI_ARGS) const {
        const int row0 = u.pm * BM + wr * 64 + fr, col0 = u.pn * BM + wc * 32 + 8 * fq;
#pragma unroll
        for (int ai = 0; ai < 2; ++ai)
#pragma unroll
            for (int m = 0; m < 4; ++m) { float* rp = H + (size_t)(row0 + ai * HALF + m * 16) * 1024 + col0;
#pragma unroll
                for (int bj = 0; bj < 2; ++bj)
#pragma unroll
                    for (int n = 0; n < 2; ++n) { f32x4* p = (f32x4*)(rp + bj * HALF + 4 * n); const f32x4 h = *p; *p = h * alpha + acc[ai][bj][m][n]; } }
    }
};

__device__ __forceinline__ float dpp_ror1(float v)  { return __int_as_float(__builtin_amdgcn_update_dpp(0, __float_as_int(v), 0x121, 0xf, 0xf, false)); }
__device__ __forceinline__ float dpp_ror15(float v) { return __int_as_float(__builtin_amdgcn_update_dpp(0, __float_as_int(v), 0x12F, 0xf, 0xf, false)); }
__device__ __forceinline__ f32x4 ror1_4(f32x4 v)  { return (f32x4){dpp_ror1(v[0]), dpp_ror1(v[1]), dpp_ror1(v[2]), dpp_ror1(v[3])}; }
__device__ __forceinline__ f32x4 ror15_4(f32x4 v) { return (f32x4){dpp_ror15(v[0]), dpp_ror15(v[1]), dpp_ror15(v[2]), dpp_ror15(v[3])}; }
struct EpiUpConv {
    static constexpr bool PERM = true, AFTER_DRAIN = false;
    bf16_t* ACT; const float* cw;
    static constexpr int S = 16384;
    __device__ __forceinline__ void operator()(AccRef acc, const Unit& u, int wr_, int wc_, int fr_, int fq_, PG8_LAS unsigned char* xlds, int wid_, int lane_) const {
        int ln; asm volatile("v_mbcnt_lo_u32_b32 %0, -1, 0\n\tv_mbcnt_hi_u32_b32 %0, -1, %0" : "=v"(ln));
        int wid = wid_; asm volatile("" : "+s"(wid));
        const int fr = ln & 15, fq = ln >> 4, wr = wid >> 2, wc = wid & 3;
        (void)wr_; (void)wc_; (void)fr_; (void)fq_; (void)lane_;
        PG8_LAS f32x4* X = (PG8_LAS f32x4*)xlds;
        if (fr == 0) {
#pragma unroll
            for (int ai = 0; ai < 2; ++ai)
#pragma unroll
                for (int bj = 0; bj < 2; ++bj)
#pragma unroll
                    for (int n = 0; n < 2; ++n) X[((((wid * 2 + ai) * 2 + 0) * 2 + bj) * 2 + n) * 4 + fq] = acc[ai][bj][0][n];
        }
        if (fr == 15) {
#pragma unroll
            for (int ai = 0; ai < 2; ++ai)
#pragma unroll
                for (int bj = 0; bj < 2; ++bj)
#pragma unroll
                    for (int n = 0; n < 2; ++n) X[((((wid * 2 + ai) * 2 + 1) * 2 + bj) * 2 + n) * 4 + fq] = acc[ai][bj][3][n];
        }
        asm volatile("s_waitcnt lgkmcnt(0)" ::: "memory"); __builtin_amdgcn_s_barrier(); asm volatile("" ::: "memory");
        const int pw = (1 - wr) * 4 + wc;
        const bool f0 = (fr == 0), f15 = (fr == 15);
        const int ubr = S - 254 * u.pm - 1; const unsigned ub = (unsigned)(ubr < 253 ? ubr : 253);
#pragma unroll
        for (int ai = 0; ai < 2; ++ai) {
            const int aip = (ai == 0) ? 0 : wr, ain = (ai == 0) ? wr : 1;
            const bool pvalid = !(ai == 0 && wr == 0), nvalid = !(ai == 1 && wr == 1);
#pragma unroll
            for (int n = 0; n < 2; ++n) {
                asm volatile("" ::: "memory");
                int zr = 0; asm volatile("" : "+v"(zr));
                const int colg = 128 * u.pn + 32 * wc + 8 * fq + 4 * n;
                const float* wp = cw + colg;
                const f32x4 g0 = *(const f32x4*)(wp), g1 = *(const f32x4*)(wp + 5632), g2 = *(const f32x4*)(wp + 2 * 5632);
                const f32x4 u0 = *(const f32x4*)(wp + 2816), u1 = *(const f32x4*)(wp + 2816 + 5632), u2 = *(const f32x4*)(wp + 2816 + 2 * 5632);
                f32x4 hpg = X[((((pw * 2 + aip) * 2 + 1) * 2 + 0) * 2 + n) * 4 + fq], hpu = X[((((pw * 2 + aip) * 2 + 1) * 2 + 1) * 2 + n) * 4 + fq];
                f32x4 hng = X[((((pw * 2 + ain) * 2 + 0) * 2 + 0) * 2 + n) * 4 + fq], hnu = X[((((pw * 2 + ain) * 2 + 0) * 2 + 1) * 2 + n) * 4 + fq];
                if (!pvalid) { hpg = (f32x4){0.f, 0.f, 0.f, 0.f}; hpu = hpg; }
                if (!nvalid) { hng = (f32x4){0.f, 0.f, 0.f, 0.f}; hnu = hng; }
                f32x4 rpg = hpg, rpu = hpu, rcg = ror15_4(acc[ai][0][0][n]), rcu = ror15_4(acc[ai][1][0][n]);
#pragma unroll
                for (int m = 0; m < 4; ++m) {
                    const f32x4 xg = acc[ai][0][m][n], xu = acc[ai][1][m][n];
                    const f32x4 rrg = ror1_4(xg), rru = ror1_4(xu);
                    f32x4 rng = hng, rnu = hnu; if (m < 3) { rng = ror15_4(acc[ai][0][m + 1][n]); rnu = ror15_4(acc[ai][1][m + 1][n]); }
                    f32x4 pg, ng, pu, nu;
#pragma unroll
                    for (int e = 0; e < 4; ++e) { pg[e] = f0 ? rpg[e] : rrg[e]; ng[e] = f15 ? rng[e] : rcg[e]; pu[e] = f0 ? rpu[e] : rru[e]; nu[e] = f15 ? rnu[e] : rcu[e]; }
                    const f32x4 yg = g0 * pg + g1 * xg + g2 * ng, yu = u0 * pu + u1 * xu + u2 * nu;
                    rpg = rrg; rpu = rru; rcg = rng; rcu = rnu;
                    const int r = ai * HALF + wr * 64 + m * 16 + fr + zr, grow = 254 * u.pm - 1 + r;
                    const f32x4 a = gelu4(yg) * yu;
                    u32x2 w; w.x = cvt_pk_bf16(a[0], a[1]); w.y = cvt_pk_bf16(a[2], a[3]);
                    if ((unsigned)(r - 1) <= ub) *(u32x2*)(ACT + (size_t)grow * 2816 + colg) = w;
                }
            }
        }
    }
};
}

namespace att {
typedef unsigned short bf16_t;
using bf16x8 = __attribute__((ext_vector_type(8))) short;
using s16x4  = __attribute__((ext_vector_type(4))) short;
using f32x16 = __attribute__((ext_vector_type(16))) float;
using u32x4  = __attribute__((ext_vector_type(4))) unsigned;
using u32x2  = __attribute__((ext_vector_type(2))) unsigned;
constexpr int NW = 8, QBLK = 32, KVBLK = 64;
constexpr int SHM_V = KVBLK * 128 * 2, SHM_K = KVBLK * 64 * 2, SHM_ATTN = 2 * SHM_V + 2 * SHM_K;
constexpr float SCALE = 0.125f;
constexpr float CEXP = SCALE * 1.4426950408889634f;
constexpr float THR = 8.f;
#define KSWZ64(row, cb) ((row) * 128 + ((cb) ^ ((((row) >> 1) & 7) << 4)))
#define ATT_SBAR() __builtin_amdgcn_sched_barrier(0)
__device__ __forceinline__ int crow(int r, int hi) { return (r & 3) + 8 * (r >> 2) + 4 * hi; }
__device__ __forceinline__ unsigned cvtpk(float lo, float hi) { return pg8::cvt_pk_bf16(lo, hi); }

template <bool MASK>
__device__ __forceinline__ void partialSM(f32x16& p0, f32x16& p1, float& m_reg, float& mn, float& alpha, int dq, int hi, int win) {
  if (MASK) {
#pragma unroll
    for (int r = 0; r < 16; ++r) { const int d0 = dq + crow(r, hi), d1 = d0 + 32;
      if (d0 > win || d0 < -win) p0[r] = -INFINITY; if (d1 > win || d1 < -win) p1[r] = -INFINITY; }
  }
  float pmax = p0[0];
#pragma unroll
  for (int r = 1; r < 16; ++r) pmax = fmaxf(pmax, p0[r]);
#pragma unroll
  for (int r = 0; r < 16; ++r) pmax = fmaxf(pmax, p1[r]);
  { auto rr = __builtin_amdgcn_permlane32_swap(__float_as_uint(pmax), __float_as_uint(pmax), false, false);
    pmax = fmaxf(__uint_as_float(rr[0]), __uint_as_float(rr[1])); }
  if (__builtin_expect(__all(pmax - m_reg <= THR / SCALE), 1)) { mn = m_reg; alpha = 1.f; }
  else { mn = fmaxf(m_reg, pmax); alpha = __builtin_amdgcn_exp2f((m_reg - mn) * CEXP); m_reg = mn; }
  const float mnC = -mn * CEXP;
#pragma unroll
  for (int r = 0; r < 16; ++r) p0[r] = fmaf(p0[r], CEXP, mnC);
#pragma unroll
  for (int r = 0; r < 16; ++r) p1[r] = fmaf(p1[r], CEXP, mnC);
#pragma unroll
  for (int r = 0; r < 16; ++r) p0[r] = __builtin_amdgcn_exp2f(p0[r]);
}
__device__ __forceinline__ void finishSM(f32x16& p0, f32x16& p1, float alpha, float& l_reg, bf16x8& pa0, bf16x8& pa1, bf16x8& pa2, bf16x8& pa3) {
#pragma unroll
  for (int r = 0; r < 16; ++r) p1[r] = __builtin_amdgcn_exp2f(p1[r]);
  float ps = 0;
#pragma unroll
  for (int r = 0; r < 16; ++r) ps += p0[r];
#pragma unroll
  for (int r = 0; r < 16; ++r) ps += p1[r];
  { auto rr = __builtin_amdgcn_permlane32_swap(__float_as_uint(ps), __float_as_uint(ps), false, false);
    ps = __uint_as_float(rr[0]) + __uint_as_float(rr[1]); }
  l_reg = l_reg * alpha + ps;
#define ATT_PK4(P, BASE, OUT) do { unsigned a0 = cvtpk(P[BASE + 0], P[BASE + 1]), a1 = cvtpk(P[BASE + 2], P[BASE + 3]);   \
    unsigned b0 = cvtpk(P[BASE + 4], P[BASE + 5]), b1 = cvtpk(P[BASE + 6], P[BASE + 7]);                              \
    auto r0 = __builtin_amdgcn_permlane32_swap(a0, b0, false, false); auto r1 = __builtin_amdgcn_permlane32_swap(a1, b1, false, false); \
    u32x4 w = {r0[0], r1[0], r0[1], r1[1]}; OUT = *reinterpret_cast<bf16x8*>(&w); } while (0)
  ATT_PK4(p0, 0, pa0); ATT_PK4(p0, 8, pa1); ATT_PK4(p1, 0, pa2); ATT_PK4(p1, 8, pa3);
#undef ATT_PK4
}
__device__ __forceinline__ void qkt(f32x16& p0, f32x16& p1, const char* Ks, const bf16x8* qr, int r32, int hi) {
  p0 = f32x16{}; p1 = f32x16{};
#pragma unroll
  for (int d0 = 0; d0 < 4; ++d0) { const int cb = (d0 * 16 + hi * 8) * 2;
    const bf16x8 b0 = *reinterpret_cast<const bf16x8*>(Ks + KSWZ64(r32, cb));
    const bf16x8 b1 = *reinterpret_cast<const bf16x8*>(Ks + KSWZ64(32 + r32, cb));
    p0 = __builtin_amdgcn_mfma_f32_32x32x16_bf16(b0, qr[d0], p0, 0, 0, 0);
    p1 = __builtin_amdgcn_mfma_f32_32x32x16_bf16(b1, qr[d0], p1, 0, 0, 0); }
}
__device__ __forceinline__ int v_st(int k, int c) { const int kk = (k & ~0xC) | ((k & 4) << 1) | ((k & 8) >> 1); return ((kk >> 3) * 4 + (c >> 5)) * 512 + ((kk & 7) * 32 + (c & 31)) * 2; }
__device__ __forceinline__ int v_rd_base(int lane) { return ((lane & 3) << 3) | (((lane >> 2) & 3) << 6) | (((lane >> 4) & 1) << 5) | (((lane >> 5) & 1) << 8); }
constexpr int v_rd_off(int d0, int ks, int half) { return d0 * 512 + ks * 4096 + half * 2048; }
template <int OFF> __device__ __forceinline__ s16x4 tr_read(int vb) {
  s16x4 r; asm volatile("ds_read_b64_tr_b16 %0, %1 offset:%2" : "=&v"(r) : "v"(vb), "i"(OFF) : "memory"); return r;
}
template <int D0> __device__ __forceinline__ void pv_one(f32x16& od, int vb, bf16x8 pa0, bf16x8 pa1, bf16x8 pa2, bf16x8 pa3) {
  const s16x4 l0 = tr_read<v_rd_off(D0, 0, 0)>(vb), h0 = tr_read<v_rd_off(D0, 0, 1)>(vb), l1 = tr_read<v_rd_off(D0, 1, 0)>(vb), h1 = tr_read<v_rd_off(D0, 1, 1)>(vb);
  const s16x4 l2 = tr_read<v_rd_off(D0, 2, 0)>(vb), h2 = tr_read<v_rd_off(D0, 2, 1)>(vb), l3 = tr_read<v_rd_off(D0, 3, 0)>(vb), h3 = tr_read<v_rd_off(D0, 3, 1)>(vb);
  asm volatile("s_waitcnt lgkmcnt(0)" ::: "memory"); ATT_SBAR();
#define ATT_PK(L, H) (bf16x8){L[0], L[1], L[2], L[3], H[0], H[1], H[2], H[3]}
  od = __builtin_amdgcn_mfma_f32_32x32x16_bf16(ATT_PK(l0, h0), pa0, od, 0, 0, 0);
  od = __builtin_amdgcn_mfma_f32_32x32x16_bf16(ATT_PK(l1, h1), pa1, od, 0, 0, 0);
  od = __builtin_amdgcn_mfma_f32_32x32x16_bf16(ATT_PK(l2, h2), pa2, od, 0, 0, 0);
  od = __builtin_amdgcn_mfma_f32_32x32x16_bf16(ATT_PK(l3, h3), pa3, od, 0, 0, 0);
#undef ATT_PK
}
template <int DV> __device__ __forceinline__ void pv_all(f32x16* o, int vb, bf16x8 pa0, bf16x8 pa1, bf16x8 pa2, bf16x8 pa3) {
  pv_one<0>(o[0], vb, pa0, pa1, pa2, pa3); pv_one<1>(o[1], vb, pa0, pa1, pa2, pa3);
  if constexpr (DV == 128) { pv_one<2>(o[2], vb, pa0, pa1, pa2, pa3); pv_one<3>(o[3], vb, pa0, pa1, pa2, pa3); }
}

__device__ __forceinline__ void glds16(const void* g, unsigned lds_base) {
  unsigned sv; asm volatile("s_mov_b32 %0, m0\n\ts_mov_b32 m0, %2\n\ts_nop 0\n\tglobal_load_lds_dwordx4 %1, off\n\ts_mov_b32 m0, %0" : "=&s"(sv) : "v"(g), "s"(lds_base) : "memory"); }
#define ATT_WAIT_BAR(N) asm volatile("s_waitcnt vmcnt(" #N ") lgkmcnt(0)\n\ts_barrier" ::: "memory")
constexpr int SLOT_K = SHM_K, SLOT_V = SHM_V, NSLOT = 3;
constexpr int LDS_KR = 0, LDS_VR = NSLOT * SLOT_K, SHM_ATTN2 = NSLOT * (SLOT_K + SLOT_V);

template <int DV, bool MASK, int ldk, int ldv>
__device__ __forceinline__ void attn_core(const int tid, const bf16_t* __restrict__ Qw, const bf16_t* __restrict__ Kh, const bf16_t* __restrict__ Vh, int NT,
                                          float m_init, float l_init, int dq0, int win, char* lds, f32x16 (&o)[DV / 32], float& l_out) {
  constexpr int NV = DV / 64;
  const int lane = tid & 63, r32 = lane & 31, hi = lane >> 5; const int wid = __builtin_amdgcn_readfirstlane(tid >> 6);
  const unsigned lds0 = (unsigned)(uintptr_t)lds;
  float m_reg = m_init, l_reg = l_init;
#pragma unroll
  for (int d = 0; d < DV / 32; ++d) o[d] = f32x16{};
  const int krow = 8 * wid + (lane >> 3);
  const bf16_t* ksrc = Kh + (size_t)krow * ldk + (((lane & 7) ^ ((krow >> 1) & 7)) * 8);
  const int vp = (DV == 128) ? wid : 2 * wid;
  const int vkk = 8 * (vp >> 1) + ((lane & 31) >> 2), vk = (vkk & ~0xC) | ((vkk & 4) << 1) | ((vkk & 8) >> 1);
  const int vc = 32 * (2 * (vp & 1) + (lane >> 5)) + 8 * (lane & 3);
  const bf16_t* vsrc = Vh + (size_t)vk * ldv + vc;
  const unsigned kdst = lds0 + LDS_KR + wid * 1024, vdst = lds0 + LDS_VR + vp * 1024;
#define ATT_DMA_K(t, slot) glds16(ksrc + (size_t)(t) * KVBLK * ldk, (unsigned)__builtin_amdgcn_readfirstlane(kdst + (slot) * SLOT_K))
#define ATT_DMA_V(t, slot) do { glds16(vsrc + (size_t)(t) * KVBLK * ldv, (unsigned)__builtin_amdgcn_readfirstlane(vdst + (slot) * SLOT_V)); \
    if constexpr (DV == 128) glds16(vsrc + (size_t)((t) * KVBLK + 32) * ldv, (unsigned)__builtin_amdgcn_readfirstlane(vdst + (slot) * SLOT_V + 8192)); } while (0)
  ATT_DMA_K(0, 0); ATT_DMA_V(0, 0); ATT_DMA_K(1, 1);
  bf16x8 qr[4];
#pragma unroll
  for (int d0 = 0; d0 < 4; ++d0) qr[d0] = *reinterpret_cast<const bf16x8*>(Qw + d0 * 16);
  const int vb0 = (int)lds0 + LDS_VR + v_rd_base(lane);
  const char* K_lds = lds + LDS_KR;
#define ATT_RESC(a) do { if (__any((a) < 1.f)) { _Pragma("unroll") for (int d = 0; d < DV / 32; ++d) _Pragma("unroll") for (int r = 0; r < 16; ++r) o[d][r] *= (a); } } while (0)
  f32x16 pA0, pA1, pB0, pB1; float mnA, mnB, alA, alB; bf16x8 pa0, pa1, pa2, pa3;
  int s_prev = 0, s_cur = 0, s_next = 1;
#define ATT_ROT() do { s_prev = s_cur; s_cur = s_next; s_next = (s_next == NSLOT - 1) ? 0 : s_next + 1; } while (0)
  if constexpr (NV == 2) ATT_WAIT_BAR(3); else ATT_WAIT_BAR(2);
  { const int s2 = 2; ATT_DMA_K(2, s2); ATT_DMA_V(1, s_next); }
  qkt(pA0, pA1, K_lds, qr, r32, hi); partialSM<MASK>(pA0, pA1, m_reg, mnA, alA, dq0, hi, win);
  if constexpr (NV == 2) ATT_WAIT_BAR(3); else ATT_WAIT_BAR(2);
  ATT_ROT();
#define ATT_STEP(C0, C1, mnC_, alC_, P0, P1, alP_, j, GK, GV, NWAIT) do { \
    if (GK) { const int s2_ = (s_next == NSLOT - 1) ? 0 : s_next + 1; ATT_DMA_K((j) + 2, s2_); } \
    if (GV) { ATT_DMA_V((j) + 1, s_next); } \
    ATT_SBAR(); qkt(C0, C1, K_lds + s_cur * SLOT_K, qr, r32, hi); \
    finishSM(P0, P1, alP_, l_reg, pa0, pa1, pa2, pa3); ATT_SBAR(); \
    pv_all<DV>(o, vb0 + s_prev * SLOT_V, pa0, pa1, pa2, pa3); partialSM<MASK>(C0, C1, m_reg, mnC_, alC_, dq0 + (j) * KVBLK, hi, win); \
    ATT_RESC(alC_); \
    ATT_WAIT_BAR(NWAIT); ATT_ROT(); } while (0)
  int j = 1;
  if constexpr (NV == 2) {
    for (; j + 3 < NT; j += 2) { ATT_STEP(pB0, pB1, mnB, alB, pA0, pA1, alA, j, true, true, 3); ATT_STEP(pA0, pA1, mnA, alA, pB0, pB1, alB, j + 1, true, true, 3); }
    ATT_STEP(pB0, pB1, mnB, alB, pA0, pA1, alA, j, true, true, 3);
    ATT_STEP(pA0, pA1, mnA, alA, pB0, pB1, alB, j + 1, false, true, 2);
    ATT_STEP(pB0, pB1, mnB, alB, pA0, pA1, alA, j + 2, false, false, 0);
  } else {
    for (; j + 3 < NT; j += 2) { ATT_STEP(pB0, pB1, mnB, alB, pA0, pA1, alA, j, true, true, 2); ATT_STEP(pA0, pA1, mnA, alA, pB0, pB1, alB, j + 1, true, true, 2); }
    ATT_STEP(pB0, pB1, mnB, alB, pA0, pA1, alA, j, true, true, 2);
    ATT_STEP(pA0, pA1, mnA, alA, pB0, pB1, alB, j + 1, false, true, 1);
    ATT_STEP(pB0, pB1, mnB, alB, pA0, pA1, alA, j + 2, false, false, 0);
  }
  finishSM(pB0, pB1, alB, l_reg, pa0, pa1, pa2, pa3); ATT_SBAR();
  pv_all<DV>(o, vb0 + s_prev * SLOT_V, pa0, pa1, pa2, pa3);
  l_out = l_reg;
#undef ATT_DMA_K
#undef ATT_DMA_V
#undef ATT_RESC
#undef ATT_ROT
#undef ATT_STEP
}
}

constexpr int NWAVES = 8;
constexpr int SEQ = 16384, DM = 1024, DEPTH = 2, DIN = 3840, NGATE = 3072, DFF = 2816, NUP = 2 * DFF;
constexpr float LN_EPS = 1e-5f;
constexpr float ALPHA = 1.4142135623730951f;
constexpr int NPHASE = 1 + 9 * DEPTH;

constexpr size_t MiB = 1u << 20;
constexpr size_t WS_CTL = 0, CTL_ZERO_BYTES = 1 * MiB;
constexpr size_t WS_COS = 1 * MiB, WS_SIN = 3 * MiB;
constexpr size_t WS_W = 5 * MiB, W_LAYER = 35 * MiB;
constexpr size_t WO_IN = 0, WO_G = 7864320, WO_BR = WO_G + 6 * MiB, WO_O = WO_BR + 3 * MiB, WO_UP = WO_O + 2 * MiB, WO_DN = WO_UP + 11 * MiB;
static_assert(WO_DN + (size_t)DM * DFF * 2 <= W_LAYER, "weight map");
constexpr size_t WS_HA = 75 * MiB;
constexpr size_t WS_YS = 107 * MiB;
constexpr size_t WS_HP = 107 * MiB;
constexpr int HP_ROWS = 1 + SEQ + 127;
constexpr size_t WS_R1 = 155 * MiB;
constexpr size_t WS_U = WS_R1, WS_DK = WS_R1 + 16 * MiB, WS_DV = WS_R1 + 32 * MiB, WS_SK = WS_R1 + 48 * MiB, WS_SV = WS_R1 + 52 * MiB;
constexpr size_t WS_GT = WS_R1;
constexpr size_t WS_ACT = WS_R1;
constexpr size_t WS_SCR = 211 * MiB;
constexpr size_t WS_END = 251 * MiB;
static_assert(WS_HP + (size_t)HP_ROWS * DM * 2 <= WS_R1 && WS_GT + (size_t)SEQ * NGATE * 2 <= WS_END && WS_SCR + 32 * MiB <= WS_END && WS_SV + 4 * MiB <= WS_SCR, "d_ws map");

constexpr int CW_BAR = 4096;
constexpr int RING_OFF = 0, RING_BYTES = 131072, XLDS_OFF = RING_BYTES, XLDS_BYTES = 8192, LDSCTL_OFF = XLDS_OFF + XLDS_BYTES, MISC_OFF = LDSCTL_OFF + 320;
constexpr int LDS_BYTES = 147456;
static_assert(MISC_OFF + 128 <= LDS_BYTES, "LDS map");

#define GAS __attribute__((address_space(1)))
#define LAS __attribute__((address_space(3)))
typedef unsigned short bf16;
typedef unsigned v4u __attribute__((ext_vector_type(4)));
typedef unsigned v2u __attribute__((ext_vector_type(2)));
typedef float f32x4 __attribute__((ext_vector_type(4)));
#define RLX_AGENT __ATOMIC_RELAXED, __HIP_MEMORY_SCOPE_AGENT
#define LDS_WAIT() asm volatile("s_waitcnt lgkmcnt(0)" ::: "memory")
#define VM_WAIT() asm volatile("s_waitcnt vmcnt(0)" ::: "memory")
__device__ __forceinline__ unsigned f2bf(float f) { unsigned u = __builtin_bit_cast(unsigned, f); return (u + 0x7fffu + ((u >> 16) & 1u)) >> 16; }
__device__ __forceinline__ unsigned pk2(float lo, float hi) { return f2bf(lo) | (f2bf(hi) << 16); }

#define XB_TMO      128
#define XB_XCNT(j)  (256  + 64 * (j))
#define XB_XSUB(j)  (1280 + 64 * (j))
#define XB_XGEN(j)  (2304 + 64 * (j))
#define XB_TOP      3328
#define XB_TOPGEN   3392
#define XCD_BAR_WORDS 3456
#define XB_SPIN_CAP (1u << 22)
__device__ __forceinline__ unsigned xb_ld(unsigned* p)              { return __hip_atomic_load(p, __ATOMIC_RELAXED, __HIP_MEMORY_SCOPE_AGENT); }
__device__ __forceinline__ unsigned xb_add(unsigned* p, unsigned v) { return __hip_atomic_fetch_add(p, v, __ATOMIC_RELAXED, __HIP_MEMORY_SCOPE_AGENT); }
__device__ __forceinline__ unsigned xb_xcc_id() { return (unsigned)__builtin_amdgcn_s_getreg((3 << 11) | 20) & 0xFu; }
#define XB_SPIN(cond, bar) do { unsigned _sp = 0; while (cond) { __builtin_amdgcn_s_sleep(1); \
    if ((++_sp & 255u) == 0u) { if (xb_ld(&(bar)[XB_TMO])) break; if (_sp > XB_SPIN_CAP) { atomicAdd(&(bar)[XB_TMO], 1u); break; } } } } while (0)
struct XcdBarrier { unsigned* bar; unsigned x; volatile LAS unsigned* st; };
__device__ __forceinline__ XcdBarrier xcd_barrier_post(unsigned* bar, volatile LAS unsigned* st) {
    XcdBarrier b; b.bar = bar; b.x = xb_xcc_id(); b.st = st;
    if (threadIdx.x == 0) (void)xb_add(&bar[XB_XCNT(b.x)], 1u);
    return b;
}
__device__ __forceinline__ void xcd_barrier_complete(unsigned* bar, unsigned x, unsigned& nloc, unsigned& nx) {
    const unsigned G = gridDim.x * gridDim.y * gridDim.z;
    unsigned sum, cnt, mine, sp = 0u;
    for (;;) {
        sum = 0u; cnt = 0u; mine = 0u;
#pragma unroll
        for (unsigned j = 0; j < 16; ++j) { const unsigned c = xb_ld(&bar[XB_XCNT(j)]); sum += c; cnt += (c > 0u) ? 1u : 0u; mine = (j == x) ? c : mine; }
        if (sum == G) break;
        __builtin_amdgcn_s_sleep(1);
        if ((++sp & 255u) == 0u) { if (xb_ld(&bar[XB_TMO])) break; if (sp > XB_SPIN_CAP) { atomicAdd(&bar[XB_TMO], 1u); break; } }
    }
    nloc = mine > 0u ? mine : 1u; nx = cnt > 0u ? cnt : 1u;
}
__device__ __forceinline__ void xcd_barrier(const XcdBarrier& b) {
    asm volatile("s_waitcnt vmcnt(0)" ::: "memory");
    __syncthreads();
    if (threadIdx.x == 0) {
        unsigned* bar = b.bar;
        __builtin_amdgcn_s_waitcnt(0);
        unsigned nloc = b.st[0], nx = b.st[1];
        if (nloc == 0u) { xcd_barrier_complete(bar, b.x, nloc, nx); b.st[0] = nloc; b.st[1] = nx; }
        const unsigned old = xb_add(&bar[XB_XSUB(b.x)], 1u);
        const unsigned gen = old / nloc;
        if (old + 1u == (gen + 1u) * nloc) {
            __builtin_amdgcn_fence(__ATOMIC_RELEASE, "agent");
            asm volatile("s_waitcnt vmcnt(0)" ::: "memory");
            const unsigned og = xb_add(&bar[XB_TOP], 1u);
            const unsigned tg = og / nx;
            if (og + 1u == (tg + 1u) * nx) xb_add(&bar[XB_TOPGEN], 1u);
            else XB_SPIN(xb_ld(&bar[XB_TOPGEN]) == tg, bar);
            __builtin_amdgcn_fence(__ATOMIC_ACQUIRE, "agent");
            xb_add(&bar[XB_XGEN(b.x)], 1u);
            asm volatile("s_waitcnt vmcnt(0)" ::: "memory");
        } else {
            XB_SPIN(xb_ld(&bar[XB_XGEN(b.x)]) == gen, bar);
            __builtin_amdgcn_fence(__ATOMIC_ACQUIRE, "agent");
            asm volatile("s_waitcnt vmcnt(0)" ::: "memory");
        }
    }
    __syncthreads();
}

__device__ __forceinline__ float wave_sum(float v) {
#pragma unroll
    for (int o = 1; o < 64; o <<= 1) v += __shfl_xor(v, o);
    return v;
}
__device__ __forceinline__ void conv_item(const float* W, int ldw, int k0, int srcc, bf16* WT, int ldt, int dstr, int dstk, LAS float* scr, int lane) {
#pragma unroll 8
    for (int i = 0; i < 32; ++i) { const int kk = 2 * i + (lane >> 5); scr[kk * 33 + (lane & 31)] = W[(size_t)(k0 + kk) * ldw + srcc + (lane & 31)]; }
    LDS_WAIT(); asm volatile("" ::: "memory");
    const int c = lane & 7;
#pragma unroll
    for (int j = 0; j < 4; ++j) { const int n = (lane >> 3) + 8 * j; const LAS float* s = scr + (8 * c) * 33 + n;
        v4u o; o.x = pk2(s[0 * 33], s[1 * 33]); o.y = pk2(s[2 * 33], s[3 * 33]); o.z = pk2(s[4 * 33], s[5 * 33]); o.w = pk2(s[6 * 33], s[7 * 33]);
        *(GAS v4u*)(WT + (size_t)(dstr + n) * ldt + dstk + 8 * c) = o; }
    LDS_WAIT(); asm volatile("" ::: "memory");
}
__device__ __forceinline__ int inmap(int gd) {
    const int tile = gd >> 3, bj = (gd >> 2) & 1, wc = gd & 3;
    if (tile < 4)  return (bj ? 1024 : 0) + 128 * tile + 32 * wc;
    if (tile < 6)  return 512 + 32 * (gd - 32);
    if (tile < 8)  return 1536 + (4 * (tile - 6) + wc) * 64 + 32 * bj;
    if (tile < 10) return 2048 + (4 * (tile - 8) + wc) * 64 + 32 * bj;
    if (tile < 12) return 2560 + 32 * (gd - 80);
    if (tile < 14) return 3072 + (4 * (tile - 12) + wc) * 64 + 32 * bj;
    return (wc < 2) ? 3584 + wc * 64 + 32 * bj : 3712 + 64 * bj + 32 * (wc - 2);
}
__device__ __forceinline__ int upmap(int gd) { const int tile = gd >> 3, bj = (gd >> 2) & 1, wc = gd & 3; return (bj ? DFF : 0) + 128 * tile + 32 * wc; }

__device__ __forceinline__ void ln_row(const float* src, const float* g, const float* b, float* dst32, bf16* dst16, int lane) {
    const f32x4* xr = (const f32x4*)src + lane;
    f32x4 v[4]; float s = 0.f;
#pragma unroll
    for (int j = 0; j < 4; ++j) { v[j] = xr[64 * j]; s += (v[j].x + v[j].y) + (v[j].z + v[j].w); }
    const float mean = wave_sum(s) * (1.f / DM); float s2 = 0.f;
#pragma unroll
    for (int j = 0; j < 4; ++j) { v[j] = v[j] - mean; s2 += (v[j].x * v[j].x + v[j].y * v[j].y) + (v[j].z * v[j].z + v[j].w * v[j].w); }
    const float rstd = 1.f / sqrtf(wave_sum(s2) * (1.f / DM) + LN_EPS);
#pragma unroll
    for (int j = 0; j < 4; ++j) { const f32x4 gg = ((const f32x4*)g)[lane + 64 * j], bb = ((const f32x4*)b)[lane + 64 * j];
        const f32x4 y = v[j] * rstd * gg + bb;
        ((f32x4*)dst32)[lane + 64 * j] = y;
        v2u w; w.x = pk2(y.x, y.y); w.y = pk2(y.z, y.w); ((v2u*)dst16)[lane + 64 * j] = w; }
}
__device__ __forceinline__ void sincos_d(double a, double& sn, double& cs) {
    const double q = __builtin_rint(a * 0.63661977236758134308);
    double r = __builtin_fma(-q, 1.57079632679489655800e+00, a); r = __builtin_fma(-q, 6.12323399573676603587e-17, r);
    const double r2 = r * r;
    double s = -7.6471637318198164759e-13; s = s * r2 + 1.6059043836821614599e-10; s = s * r2 - 2.5052108385441718775e-08; s = s * r2 + 2.7557319223985890653e-06;
    s = s * r2 - 1.9841269841269841270e-04; s = s * r2 + 8.3333333333333333333e-03; s = s * r2 - 1.6666666666666666667e-01; s = r + r * r2 * s;
    double c = 4.7794773323873852974e-14; c = c * r2 - 1.1470745597729724714e-11; c = c * r2 + 2.0876756987868098979e-09; c = c * r2 - 2.7557319223985890653e-07;
    c = c * r2 + 2.4801587301587301587e-05; c = c * r2 - 1.3888888888888888889e-03; c = c * r2 + 4.1666666666666666667e-02; c = c * r2 - 0.5; c = c * r2 + 1.0;
    const int qi = (int)((long long)q & 3);
    sn = (qi == 0) ? s : (qi == 1) ? c : (qi == 2) ? -s : -c;
    cs = (qi == 0) ? c : (qi == 1) ? -s : (qi == 2) ? -c : s;
}
__device__ __forceinline__ float rope_theta_pow(int i) {
    constexpr double T[32] = {1, 1.333521432163324, 1.7782794100389228, 2.3713737056616551, 3.1622776601683795, 4.2169650342858223, 5.6234132519034912, 7.4989420933245583, 10, 13.33521432163324,
        17.782794100389228, 23.713737056616552, 31.622776601683793, 42.169650342858226, 56.234132519034908, 74.989420933245583, 100, 133.35214321633239, 177.82794100389228, 237.13737056616552,
        316.22776601683796, 421.69650342858228, 562.34132519034904, 749.89420933245583, 1000, 1333.5214321633241, 1778.2794100389228, 2371.3737056616551, 3162.2776601683795, 4216.9650342858222,
        5623.4132519034911, 7498.9420933245583};
    return (float)T[i];
}

#ifndef MK_DIAG
#define MK_DIAG -1
#endif
#define PH_EN(k) ((MK_DIAG) < 0 || (MK_DIAG) == (k))
#ifndef ATT_SD
#define ATT_SD 1
#endif
struct Params { const float* in[20]; float* out; unsigned char* ws; int ph_lo, ph_hi, li, pad; };
enum { I_X = 0, I_POS, I_LNG, I_LNB, I_WIN, I_CONVW, I_DLAM, I_SUBG, I_SINK, I_WGATE, I_BGATE, I_WBR, I_WO, I_LMG, I_LMB, I_WUP, I_FCW, I_WDN, I_LFG, I_LFB };

template <int SUB>
__device__ __forceinline__ void run_phase(const int l, const int wave_s, LAS unsigned char* L, unsigned char* lds) {
        int lane_; asm volatile("v_mbcnt_lo_u32_b32 %0, -1, 0\n\tv_mbcnt_hi_u32_b32 %0, -1, %0" : "=v"(lane_));
        int bx = blockIdx.x, G = gridDim.x, wave = wave_s;
        asm volatile("" : "+s"(bx)); asm volatile("" : "+s"(G)); asm volatile("" : "+s"(wave));
        const int lane = lane_, tid = wave * 64 + lane_;
        const int vcu = (G % 8 == 0) ? (bx % 8) * (G / 8) + bx / 8 : bx;
        const int gw = vcu * NWAVES + wave, NGW = G * NWAVES;
        const __attribute__((address_space(4))) Params* pp = (const __attribute__((address_space(4))) Params*)__builtin_amdgcn_kernarg_segment_ptr();
        asm volatile("" : "+s"(pp));
#define PIN(i) (pp->in[i])
        unsigned char* ws = pp->ws;
        float* H32 = pp->out;
        float* COS = (float*)(ws + WS_COS); float* SIN = (float*)(ws + WS_SIN);
        bf16* HA = (bf16*)(ws + WS_HA); bf16* YS = (bf16*)(ws + WS_YS); bf16* HP = (bf16*)(ws + WS_HP);
        bf16* UB = (bf16*)(ws + WS_U); bf16* DKB = (bf16*)(ws + WS_DK); bf16* DVB = (bf16*)(ws + WS_DV); bf16* SKB = (bf16*)(ws + WS_SK); bf16* SVB = (bf16*)(ws + WS_SV);
        bf16* GT = (bf16*)(ws + WS_GT); bf16* ACT = (bf16*)(ws + WS_ACT); float* SCR = (float*)(ws + WS_SCR);
        unsigned char* wl = ws + WS_W + (size_t)l * W_LAYER;
        (void)lane; (void)gw; (void)NGW; (void)H32; (void)COS; (void)SIN; (void)HA; (void)YS; (void)HP; (void)UB; (void)DKB; (void)DVB; (void)SKB; (void)SVB; (void)GT; (void)ACT; (void)SCR; (void)wl; (void)vcu;
        if constexpr (SUB == -1) {
            LAS float* scr = (LAS float*)(L + RING_OFF + wave * 16384);
            constexpr int N_IN = 16 * 120, N_G = 16 * 96, N_BR = 3 * 8 * 32, N_O = 16 * 32, N_UP = 16 * 176, N_DN = 44 * 32, N_L = N_IN + N_G + N_BR + N_O + N_UP + N_DN;
            for (int it = gw; it < DEPTH * N_L; it += NGW) {
                const int ll = it / N_L; int r = it - ll * N_L; unsigned char* wb = ws + WS_W + (size_t)ll * W_LAYER;
                if (r < N_IN) { const int kb = r / 120, gd = r % 120; conv_item(PIN(I_WIN) + (size_t)ll * DM * DIN, DIN, kb * 64, inmap(gd), (bf16*)(wb + WO_IN), DM, gd * 32, kb * 64, scr, lane); continue; } r -= N_IN;
                if (r < N_G) { const int kb = r / 96, gd = r % 96; conv_item(PIN(I_WGATE) + (size_t)ll * DM * NGATE, NGATE, kb * 64, gd * 32, (bf16*)(wb + WO_G), DM, gd * 32, kb * 64, scr, lane); continue; } r -= N_G;
                if (r < N_BR) { const int n = r / 256, rr = r % 256, kb = rr / 32, gd = rr % 32; conv_item(PIN(I_WBR) + (size_t)(ll * 3 + n) * 512 * DM, DM, kb * 64, gd * 32, (bf16*)(wb + WO_BR), 1536, gd * 32, n * 512 + kb * 64, scr, lane); continue; } r -= N_BR;
                if (r < N_O) { const int kb = r / 32, gd = r % 32; conv_item(PIN(I_WO) + (size_t)ll * DM * DM, DM, kb * 64, gd * 32, (bf16*)(wb + WO_O), DM, gd * 32, kb * 64, scr, lane); continue; } r -= N_O;
                if (r < N_UP) { const int kb = r / 176, gd = r % 176; conv_item(PIN(I_WUP) + (size_t)ll * DM * NUP, NUP, kb * 64, upmap(gd), (bf16*)(wb + WO_UP), DM, gd * 32, kb * 64, scr, lane); continue; } r -= N_UP;
                { const int kb = r / 32, gd = r % 32; conv_item(PIN(I_WDN) + (size_t)ll * DFF * DM, DM, kb * 64, gd * 32, (bf16*)(wb + WO_DN), DFF, gd * 32, kb * 64, scr, lane); }
            }
            const int* pos = (const int*)PIN(I_POS);
            for (int idx = vcu * 512 + tid; idx < SEQ * 32; idx += G * 512) {
                const int t = idx >> 5, i = idx & 31;
                const float inv = 1.0f / rope_theta_pow(i);
                const float ang = (float)pos[t] * inv;
                double sd, cd; sincos_d((double)ang, sd, cd);
                COS[idx] = (float)cd; SIN[idx] = (float)sd;
            }
            for (int m = gw; m < SEQ; m += NGW) ln_row(PIN(I_X) + (size_t)m * DM, PIN(I_LNG), PIN(I_LNB), H32 + (size_t)m * DM, HA + (size_t)m * DM, lane);
        } else if constexpr (SUB == 0) {
            pg8::Gemm g{HA, (const bf16*)(wl + WO_IN), DM, DM, DM}; pg8::StaticOrder S; S.init(SEQ / 256, DIN / 256, G, bx, 256);
            pg8::EpiInProj E{UB, YS, DKB, DVB, SKB, SVB, COS, SIN};
            pg8::gemm_phase<pg8::EpiInProj, pg8::StaticOrder, true>(tid, L + RING_OFF, L + XLDS_OFF, g, S, E);
        } else if constexpr (SUB == 1) {
            char* al = (char*)lds;
            const int r32 = lane & 31, hi = lane >> 5;
            const float lambda_init = (l == 0) ? 0.2f : 0.35550906759096934f;
#ifndef MK_NO_DIFF
            for (int pair = vcu; pair < 256; pair += G) {
                const int h = pair >> 6, qb = pair & 63;
                const size_t qrow = (size_t)qb * 256 + wave * 32 + r32;
                f32x4* scr = (f32x4*)(SCR + ((size_t)(pair * 8 + wave) * 64 + lane) * 64);
                att::f32x16 o[4]; float lsum;
                att::attn_core<128, false, 512, 512>(tid, YS + qrow * 1536 + 512 + h * 128 + hi * 8, DKB + h * 128, DVB + h * 128, SEQ / 64, -1e30f, 0.f, 0, 0, al, o, lsum);
                { const float rl = 1.0f / lsum;
#pragma unroll
                  for (int d = 0; d < 4; ++d)
#pragma unroll
                      for (int g4 = 0; g4 < 4; ++g4) scr[d * 4 + g4] = (f32x4){o[d][4 * g4] * rl, o[d][4 * g4 + 1] * rl, o[d][4 * g4 + 2] * rl, o[d][4 * g4 + 3] * rl}; }
                __syncthreads();
                att::attn_core<128, false, 512, 512>(tid, YS + qrow * 1536 + 512 + h * 128 + 64 + hi * 8, DKB + h * 128 + 64, DVB + h * 128, SEQ / 64, -1e30f, 0.f, 0, 0, al, o, lsum);
                const float* lp = PIN(I_DLAM) + l * 256;
                const float s01 = wave_sum(lp[lane] * lp[64 + lane]), s23 = wave_sum(lp[128 + lane] * lp[192 + lane]);
                const float lam = __builtin_amdgcn_exp2f(s01 * 1.4426950408889634f) - __builtin_amdgcn_exp2f(s23 * 1.4426950408889634f) + lambda_init;
                const float rl1 = lam / lsum; float ss = 0.f;
                VM_WAIT();
#pragma unroll
                for (int d = 0; d < 4; ++d)
#pragma unroll
                    for (int g4 = 0; g4 < 4; ++g4) { const f32x4 sv = scr[d * 4 + g4];
#pragma unroll
                        for (int e = 0; e < 4; ++e) { const float y = sv[e] - o[d][4 * g4 + e] * rl1; o[d][4 * g4 + e] = y; ss += y * y; } }
                { auto rr = __builtin_amdgcn_permlane32_swap(__float_as_uint(ss), __float_as_uint(ss), false, false); ss = __uint_as_float(rr[0]) + __uint_as_float(rr[1]); }
                const float rms = (1.0f - lambda_init) / sqrtf(ss * (1.0f / 128.0f) + LN_EPS);
                const float* sg = PIN(I_SUBG) + l * 128;
                bf16* op = YS + qrow * 1536 + 512 + h * 128;
#pragma unroll
                for (int d = 0; d < 4; ++d)
#pragma unroll
                    for (int g4 = 0; g4 < 4; ++g4) { const int dc = 32 * d + 8 * g4 + 4 * hi; const f32x4 gg = *(const f32x4*)(sg + dc);
                        v2u w; w.x = pk2(o[d][4 * g4] * rms * gg.x, o[d][4 * g4 + 1] * rms * gg.y); w.y = pk2(o[d][4 * g4 + 2] * rms * gg.z, o[d][4 * g4 + 3] * rms * gg.w);
                        *(v2u*)(op + dc) = w; }
                __syncthreads();
            }
#endif
#ifndef MK_NO_SWA
            for (int su = vcu; su < 512; su += G) {
                const int hq = su >> 6, qb = su & 63, q0 = qb * 256, kvh = hq >> 2;
                const int ks = (q0 - 128 < 0) ? 0 : q0 - 128, ke = (q0 + 384 > SEQ) ? SEQ : q0 + 384, NT = (ke - ks) / 64;
                const int qpos = q0 + wave * 32 + r32;
                att::f32x16 o[2]; float lsum;
                att::attn_core<64, true, 128, 128>(tid, YS + (size_t)qpos * 1536 + 1024 + hq * 64 + hi * 8, SKB + (size_t)ks * 128 + kvh * 64, SVB + (size_t)ks * 128 + kvh * 64, NT,
                                         PIN(I_SINK)[l * 8 + hq] * 8.0f, 1.0f, ks - qpos, 128, al, o, lsum);
                const float rl = 1.0f / lsum;
                bf16* op = YS + (size_t)qpos * 1536 + 1024 + hq * 64;
#pragma unroll
                for (int d = 0; d < 2; ++d)
#pragma unroll
                    for (int g4 = 0; g4 < 4; ++g4) { const int dc = 32 * d + 8 * g4 + 4 * hi;
                        v2u w; w.x = pk2(o[d][4 * g4] * rl, o[d][4 * g4 + 1] * rl); w.y = pk2(o[d][4 * g4 + 2] * rl, o[d][4 * g4 + 3] * rl);
                        *(v2u*)(op + dc) = w; }
                __syncthreads();
            }
#endif
            const float* cw = PIN(I_CONVW) + l * 3 * 512;
            for (int idx = vcu * 512 + tid; idx < SEQ * 64; idx += G * 512) {
                const int t = idx >> 6, c8 = (idx & 63) * 8;
                const v4u z = {0u, 0u, 0u, 0u};
                const v4u uc = *(const v4u*)(UB + (size_t)t * 512 + c8);
                const v4u up = (t > 0) ? *(const v4u*)(UB + (size_t)(t - 1) * 512 + c8) : z;
                const v4u un = (t < SEQ - 1) ? *(const v4u*)(UB + (size_t)(t + 1) * 512 + c8) : z;
                const v4u ab = *(const v4u*)(YS + (size_t)t * 1536 + c8);
                f32x4 ca, cb, pa, pb, na, nb, ba, bb; pg8::unpack8(uc, ca, cb); pg8::unpack8(up, pa, pb); pg8::unpack8(un, na, nb); pg8::unpack8(ab, ba, bb);
                const f32x4 w0a = *(const f32x4*)(cw + c8), w0b = *(const f32x4*)(cw + c8 + 4), w1a = *(const f32x4*)(cw + 512 + c8), w1b = *(const f32x4*)(cw + 512 + c8 + 4);
                const f32x4 w2a = *(const f32x4*)(cw + 1024 + c8), w2b = *(const f32x4*)(cw + 1024 + c8 + 4);
                const f32x4 ya = ba * (w0a * pa + w1a * ca + w2a * na), yb = bb * (w0b * pb + w1b * cb + w2b * nb);
                *(v4u*)(YS + (size_t)t * 1536 + c8) = pg8::pack8(ya, yb);
            }
        } else if constexpr (SUB == 2) {
            pg8::Gemm g{HA, (const bf16*)(wl + WO_G), DM, DM, DM}; pg8::StaticOrder S; S.init(SEQ / 256, NGATE / 256, G, bx, 256);
            pg8::EpiGates E{GT, PIN(I_BGATE) + l * NGATE};
            pg8::gemm_phase<pg8::EpiGates, pg8::StaticOrder, true>(tid, L + RING_OFF, L + XLDS_OFF, g, S, E);
        } else if constexpr (SUB == 3) {
            pg8::Gemm g{YS, (const bf16*)(wl + WO_BR), 1536, 1536, 512}; pg8::SegOrder S; S.init(SEQ / 256, DM / 256, G, bx, 3, 512);
            pg8::EpiBranch E{HA, GT};
            pg8::gemm_phase<pg8::EpiBranch, pg8::SegOrder, true>(tid, L + RING_OFF, L + XLDS_OFF, g, S, E);
        } else if constexpr (SUB == 4 || SUB == 7) {
            pg8::Gemm g{(SUB == 4) ? HA : ACT, (const bf16*)(wl + ((SUB == 4) ? WO_O : WO_DN)), (SUB == 4) ? DM : DFF, (SUB == 4) ? DM : DFF, (SUB == 4) ? DM : DFF};
            pg8::StaticOrder S; S.init(SEQ / 256, DM / 256, G, bx, 256);
            pg8::EpiResid E{H32, ALPHA};
            pg8::gemm_phase<pg8::EpiResid, pg8::StaticOrder, true>(tid, L + RING_OFF, L + XLDS_OFF, g, S, E);
        } else if constexpr (SUB == 5 || SUB == 8) {
            const float* gg = PIN((SUB == 5) ? I_LMG : I_LFG) + l * DM; const float* bb = PIN((SUB == 5) ? I_LMB : I_LFB) + l * DM;
            bf16* dst = (SUB == 5) ? HP + DM : HA;
            for (int m = gw; m < SEQ; m += NGW) ln_row(H32 + (size_t)m * DM, gg, bb, H32 + (size_t)m * DM, dst + (size_t)m * DM, lane);
            if (SUB == 5) {
                for (int idx = vcu * 512 + tid; idx < 128 * (DM / 8); idx += G * 512) { const int rr = idx / (DM / 8), c8 = (idx % (DM / 8)) * 8; const int row = (rr == 0) ? 0 : SEQ + rr;
                    *(v4u*)(HP + (size_t)row * DM + c8) = (v4u){0u, 0u, 0u, 0u}; }
            }
        } else if constexpr (SUB == 9) {
#ifdef MK_DUMP
            for (int idx = vcu * 512 + tid; idx < SEQ * 128; idx += G * 512) {
                const int t = idx >> 7, c8 = (idx & 127) * 8;
                const bf16* src;
                if (MK_DUMP == 1) src = YS + (size_t)t * 1536 + c8;
                else if (MK_DUMP == 2) src = YS + (size_t)t * 1536 + 512 + c8;
                else if (MK_DUMP == 3) src = UB + (size_t)t * 512 + (c8 & 511);
                else if (MK_DUMP == 4) src = (c8 < 512) ? DKB + (size_t)t * 512 + c8 : DVB + (size_t)t * 512 + (c8 - 512);
                else if (MK_DUMP == 5) src = (c8 < 512) ? SKB + (size_t)t * 128 + (c8 & 127) : SVB + (size_t)t * 128 + (c8 & 127);
                else if (MK_DUMP == 6) src = GT + (size_t)t * 3072 + c8;
                else if (MK_DUMP == 7) src = GT + (size_t)t * 3072 + 1024 + c8;
                else if (MK_DUMP == 8) src = GT + (size_t)t * 3072 + 2048 + c8;
                else src = HA + (size_t)t * 1024 + c8;
                const v4u w = *(const v4u*)src; f32x4 a, b; pg8::unpack8(w, a, b);
                *(f32x4*)(H32 + (size_t)t * 1024 + c8) = a; *(f32x4*)(H32 + (size_t)t * 1024 + c8 + 4) = b;
            }
#endif
        } else if constexpr (SUB == 6) {
            pg8::Gemm g{HP, (const bf16*)(wl + WO_UP), DM, DM, DM}; pg8::StaticOrder S; S.init(65, NUP / 256, G, bx, 254);
            pg8::EpiUpConv E{ACT, PIN(I_FCW) + (size_t)l * 3 * NUP};
            pg8::gemm_phase<pg8::EpiUpConv, pg8::StaticOrder, true>(tid, L + RING_OFF, L + XLDS_OFF, g, S, E);
        }
#undef PIN
}

__global__ void __launch_bounds__(NWAVES * 64, 2) mk_fwd(Params p) {
    extern __shared__ __attribute__((aligned(16))) unsigned char lds[];
    LAS unsigned char* L = (LAS unsigned char*)lds;
    volatile LAS unsigned* MISC = (volatile LAS unsigned*)(L + MISC_OFF);
    for (int u = threadIdx.x; u < (LDS_BYTES - LDSCTL_OFF) / 4; u += NWAVES * 64) ((LAS unsigned*)(L + LDSCTL_OFF))[u] = 0u;
    __syncthreads();
    const int wave_s = __builtin_amdgcn_readfirstlane((int)threadIdx.x >> 6);
#if MK_ONE_LAUNCH
    (void)xcd_barrier_post((unsigned*)(p.ws + WS_CTL) + CW_BAR, MISC + 8);
#define GRID_BAR() do { XcdBarrier bar_; bar_.bar = (unsigned*)(((const __attribute__((address_space(4))) Params*)__builtin_amdgcn_kernarg_segment_ptr())->ws + WS_CTL) + CW_BAR; bar_.x = xb_xcc_id(); bar_.st = MISC + 8; xcd_barrier(bar_); } while (0)
    constexpr int lo = 0, hi = NPHASE;
#else
    (void)MISC;
#define GRID_BAR() do {} while (0)
    const int lo = p.ph_lo, hi = p.ph_hi;
#endif
#ifdef MK_LEAK
#define STAMP(k) do { if (blockIdx.x == 0 && threadIdx.x == 0) ((unsigned long long*)(p.ws + WS_CTL))[16 + (k)] = __builtin_amdgcn_s_memrealtime(); } while (0)
#else
#define STAMP(k) do {} while (0)
#endif
#define PH(k, SUBV, lv) if (PH_EN(k) && lo <= (k) && (k) < hi) { STAMP(k); run_phase<SUBV>(lv, wave_s, L, lds); if ((k) + 1 < hi) GRID_BAR(); }
    PH(0, -1, 0)
    PH(1, 0, 0) PH(2, 1, 0) PH(3, 2, 0) PH(4, 3, 0) PH(5, 4, 0) PH(6, 5, 0) PH(7, 6, 0) PH(8, 7, 0) PH(9, 8, 0)
    PH(10, 0, 1) PH(11, 1, 1) PH(12, 2, 1) PH(13, 3, 1) PH(14, 4, 1) PH(15, 5, 1) PH(16, 6, 1) PH(17, 7, 1) PH(18, 8, 1)
#ifdef MK_DUMP
    PH(19, 9, 0)
#endif
#ifdef MK_LEAK
    STAMP(19);
    __syncthreads();
    if (blockIdx.x == 0 && threadIdx.x == 0) { asm volatile("s_waitcnt vmcnt(0)" ::: "memory"); const unsigned long long* st = (const unsigned long long*)(p.ws + WS_CTL) + 16;
        p.out[0] += (float)(st[MK_LEAK_END] - st[MK_LEAK]) * 0.01f * MK_LEAK_SCALE; }
#endif
#undef PH
}

extern "C" void kernel_launch(void* const* d_in, const int* in_sizes, int n_in, void* d_out, int out_size, void* d_ws, size_t ws_size, hipStream_t stream) {
    static int grid = 0;
    if (grid == 0) {
        if (n_in != 20 || in_sizes[0] != SEQ * DM || out_size != SEQ * DM || ws_size < WS_END) { fprintf(stderr, "kernel_launch: shape/workspace mismatch n_in %d in0 %d out %d ws %zu (need %zu)\n", n_in, n_in > 0 ? in_sizes[0] : -1, out_size, ws_size, (size_t)WS_END); grid = -1; return; }
        int dev = 0, cus = 0, per_cu = 0;
        if (hipGetDevice(&dev) != hipSuccess || hipDeviceGetAttribute(&cus, hipDeviceAttributeMultiprocessorCount, dev) != hipSuccess) { grid = -1; return; }
        if (hipFuncSetAttribute((const void*)mk_fwd, hipFuncAttributeMaxDynamicSharedMemorySize, LDS_BYTES) != hipSuccess) { fprintf(stderr, "kernel_launch: hipFuncSetAttribute failed\n"); grid = -1; return; }
        if (hipOccupancyMaxActiveBlocksPerMultiprocessor(&per_cu, (const void*)mk_fwd, NWAVES * 64, LDS_BYTES) != hipSuccess || per_cu < 1) { fprintf(stderr, "kernel_launch: occupancy query says %d blocks per CU\n", per_cu); (void)hipGetLastError(); grid = -1; return; }
        grid = cus;
    }
    if (grid < 0) return;
    if (hipMemsetAsync((char*)d_ws + WS_CTL, 0, CTL_ZERO_BYTES, stream) != hipSuccess) return;
    Params a{};
    for (int i = 0; i < 20; ++i) a.in[i] = (const float*)d_in[i];
    a.out = (float*)d_out; a.ws = (unsigned char*)d_ws; a.li = 0; a.pad = 0;
#if MK_ONE_LAUNCH
    a.ph_lo = 0; a.ph_hi = NPHASE;
    hipLaunchKernelGGL(mk_fwd, dim3(grid), dim3(NWAVES * 64), LDS_BYTES, stream, a);
#else
#ifdef MK_PHLIST
    { const int phl[] = MK_PHLIST; for (int i = 0; i < (int)(sizeof(phl) / sizeof(int)); ++i) { a.ph_lo = phl[i]; a.ph_hi = phl[i] + 1; hipLaunchKernelGGL(mk_fwd, dim3(grid), dim3(NWAVES * 64), LDS_BYTES, stream, a); } }
#else
    for (int ph = 0; ph < NPHASE; ++ph) { a.ph_lo = ph; a.ph_hi = ph + 1; hipLaunchKernelGGL(mk_fwd, dim3(grid), dim3(NWAVES * 64), LDS_BYTES, stream, a); }
#endif
#endif
    const hipError_t le = hipPeekAtLastError();
    if (le != hipSuccess) fprintf(stderr, "kernel_launch: launch failed: %s\n", hipGetErrorName(le));
}
```

```cpp
#include <hip/hip_runtime.h>
#include <hip/hip_bf16.h>
#include <cstdio>
#include <cstdint>

#ifndef MK_ONE_LAUNCH
#define MK_ONE_LAUNCH 1
#endif

namespace pg8 {
#define PG8_LAS __attribute__((address_space(3)))
typedef unsigned short bf16_t;
typedef short bf16x8 __attribute__((ext_vector_type(8)));
typedef float f32x4 __attribute__((ext_vector_type(4)));
typedef float f32x2 __attribute__((ext_vector_type(2)));
typedef unsigned u32x4 __attribute__((ext_vector_type(4)));
typedef unsigned u32x2 __attribute__((ext_vector_type(2)));
constexpr int BM = 256, BK = 64, HALF = 128, HTB = HALF * BK * 2  , STAGE_BYTES = 8 * HTB, NXCD = 8, WGM = 8;

__host__ __device__ __forceinline__ int lds_byte(int r, int c) { const int st = (r >> 4) * 2 + (c >> 5), rr = r & 15, cc = c & 31, ob = rr * 64 + cc * 2; return st * 1024 + (ob ^ (((ob >> 9) & 1) << 5)); }
__host__ __device__ __forceinline__ void stage_rc(int b, int& R, int& C) { const int st = b / 1024, sb = b % 1024, swz = sb ^ (((sb >> 9) & 1) << 5); R = (st >> 1) * 16 + swz / 64; C = (st & 1) * 32 + (swz % 64) / 2; }
__host__ __device__ __forceinline__ int perm32(int rho) { const int n = rho >> 4, i = rho & 15; return 8 * (i >> 2) + 4 * n + (i & 3); }

struct Unit { int pm, pn, arow, brow, kofs, seg; };
struct Gemm { const bf16_t* A; const bf16_t* Bt; int lda, ldb, K; };

struct StaticOrder {
    int nM, nN, nwg, G, c, rowstep;
    __device__ void init(int nM_, int nN_, int G_, int c_, int rowstep_) { nM = nM_; nN = nN_; nwg = nM * nN; G = G_; c = c_; rowstep = rowstep_; }
    __device__ bool next(int i, Unit& u) const {
        const long L = (long)i * G + c; if (L >= nwg) return false;
        int wgid = (int)L; { const int q = nwg / NXCD, r = nwg % NXCD, xcd = wgid % NXCD, off = wgid / NXCD; wgid = (xcd < r ? xcd * (q + 1) : r * (q + 1) + (xcd - r) * q) + off; }
        const int nig = WGM * nN, gid = wgid / nig, fm = gid * WGM, gsz = (nM - fm) < WGM ? (nM - fm) : WGM;
        u.pm = fm + ((wgid % nig) % gsz); u.pn = (wgid % nig) / gsz; u.arow = u.pm * rowstep; u.brow = u.pn * BM; u.kofs = 0; u.seg = 0; return true;
    }
};
struct SegOrder {
    StaticOrder so; int nseg, klen;
    __device__ void init(int nM_, int nN_, int G_, int c_, int nseg_, int klen_) { so.init(nM_, nN_, G_, c_, BM); nseg = nseg_; klen = klen_; }
    __device__ bool next(int i, Unit& u) const { const int t = i / nseg, s = i - t * nseg; if (!so.next(t, u)) return false; u.kofs = s * klen; u.seg = s; return true; }
};

typedef __bf16 bf16x2_t __attribute__((ext_vector_type(2)));
__device__ __forceinline__ unsigned cvt_pk_bf16(float lo, float hi) { f32x2 v = {lo, hi}; bf16x2_t b = __builtin_convertvector(v, bf16x2_t); return __builtin_bit_cast(unsigned, b); }
__device__ __forceinline__ float bf_lo(unsigned w) { return __uint_as_float(w << 16); }
__device__ __forceinline__ float bf_hi(unsigned w) { return __uint_as_float(w & 0xffff0000u); }
__device__ __forceinline__ u32x4 pack8(const f32x4 a, const f32x4 b) { u32x4 w; w.x = cvt_pk_bf16(a[0], a[1]); w.y = cvt_pk_bf16(a[2], a[3]); w.z = cvt_pk_bf16(b[0], b[1]); w.w = cvt_pk_bf16(b[2], b[3]); return w; }
__device__ __forceinline__ void unpack8(const u32x4 w, f32x4& a, f32x4& b) { a = (f32x4){bf_lo(w.x), bf_hi(w.x), bf_lo(w.y), bf_hi(w.y)}; b = (f32x4){bf_lo(w.z), bf_hi(w.z), bf_lo(w.w), bf_hi(w.w)}; }
__device__ __forceinline__ f32x2 gelu_pk(f32x2 v) {
    const f32x2 av = __builtin_elementwise_abs(v), d = av * 0.2316418882f + 1.0f;
    f32x2 t; t.x = __builtin_amdgcn_rcpf(d.x); t.y = __builtin_amdgcn_rcpf(d.y);
    f32x2 q = t * 0.5307027145f + (-0.7265760135f); q = q * t + 0.7107068705f; q = q * t + (-0.142248368f); q = q * t + 0.127414796f; q = q * t;
    const f32x2 s = (v * v) * (-0.72134752044f);
    f32x2 e; e.x = __builtin_amdgcn_exp2f(s.x); e.y = __builtin_amdgcn_exp2f(s.y);
    const f32x2 m = v * (q * e), r = v - m;
    f32x2 o; o.x = v.x < 0.f ? m.x : r.x; o.y = v.y < 0.f ? m.y : r.y; return o;
}
__device__ __forceinline__ f32x4 gelu4(f32x4 v) { f32x2 a = gelu_pk((f32x2){v[0], v[1]}), b = gelu_pk((f32x2){v[2], v[3]}); return (f32x4){a.x, a.y, b.x, b.y}; }

template <class Epi, class Sched, bool ALIGN_EPI>
__device__ __forceinline__ void gemm_phase(const int tid, PG8_LAS unsigned char* lds, PG8_LAS unsigned char* xlds, const Gemm g, const Sched& S, const Epi& E) {
    const int wid = __builtin_amdgcn_readfirstlane(tid >> 6), lane = tid & 63, wr = wid >> 2, wc = wid & 3, fr = lane & 15, fq = lane >> 4;
    const int K = g.K, nt = K / BK;
    unsigned voffA[2], voffB[2];
#pragma unroll
    for (int i = 0; i < 2; ++i) { int R, C; stage_rc(tid * 16 + i * 8192, R, C); const int Rb = Epi::PERM ? ((R & ~31) + perm32(R & 31)) : R;
        voffA[i] = (unsigned)(R * g.lda + C) * 2u; voffB[i] = (unsigned)(Rb * g.ldb + C) * 2u; }
    const size_t kstep = (size_t)(BK * 2);
    const size_t hstepA = (size_t)HALF * g.lda * 2, hstepB = (size_t)HALF * g.ldb * 2;
    const unsigned ldsw = (unsigned)wid * 1024u;
    const int aoff = lds_byte(wr * 64 + fr, fq * 8), boff = lds_byte(wc * 32 + fr, fq * 8);
#define PG8_SA(b, h) (((b) * 2 + (h)) * HTB)
#define PG8_SB(b, h) ((4 + (b) * 2 + (h)) * HTB)
#define PG8_STAGE(bufoff, gbase, voff) do { _Pragma("unroll") for (int _i = 0; _i < 2; ++_i) \
        __builtin_amdgcn_global_load_lds((const unsigned*)((const char*)(gbase) + (voff)[_i]), (PG8_LAS unsigned*)(lds + (bufoff) + ldsw + _i * 8192), 16, 0, 0); } while (0)
#define PG8_LDA(dst, b, h) do { _Pragma("unroll") for (int m = 0; m < 4; ++m) _Pragma("unroll") for (int k = 0; k < 2; ++k) dst[m][k] = *(const PG8_LAS bf16x8*)(lds + PG8_SA(b, h) + aoff + m * 2048 + k * 1024); } while (0)
#define PG8_LDB(dst, b, h) do { _Pragma("unroll") for (int n = 0; n < 2; ++n) _Pragma("unroll") for (int k = 0; k < 2; ++k) dst[n][k] = *(const PG8_LAS bf16x8*)(lds + PG8_SB(b, h) + boff + n * 2048 + k * 1024); } while (0)
#define PG8_MMA(ai, bj, At, Bt) do { __builtin_amdgcn_s_setprio(1); _Pragma("unroll") for (int m = 0; m < 4; ++m) _Pragma("unroll") for (int n = 0; n < 2; ++n) _Pragma("unroll") for (int k = 0; k < 2; ++k) \
        acc[ai][bj][m][n] = __builtin_amdgcn_mfma_f32_16x16x32_bf16(Bt[n][k], At[m][k], acc[ai][bj][m][n], 0, 0, 0); __builtin_amdgcn_s_setprio(0); } while (0)
#define PG8_WAIT_V(n) asm volatile("s_waitcnt vmcnt(" #n ")" ::: "memory")
#define PG8_WAIT_L(n) asm volatile("s_waitcnt lgkmcnt(" #n ")" ::: "memory")
#define PG8_BAR __builtin_amdgcn_s_barrier()
#define PG8_SCHED __builtin_amdgcn_sched_barrier(0)
    Unit cur, nxt; int ui = 0;
    if (!S.next(0, cur)) return;
    f32x4 acc[2][2][4][2];
#pragma unroll
    for (int a = 0; a < 2; ++a)
#pragma unroll
        for (int b = 0; b < 2; ++b)
#pragma unroll
            for (int m = 0; m < 4; ++m)
#pragma unroll
                for (int n = 0; n < 2; ++n) acc[a][b][m][n] = (f32x4){0.f, 0.f, 0.f, 0.f};
    bf16x8 At[4][2], B0[2][2], B1[2][2];
    const char* cA = (const char*)g.A + ((size_t)cur.arow * g.lda + cur.kofs) * 2; const char* cB = (const char*)g.Bt + ((size_t)cur.brow * g.ldb + cur.kofs) * 2;
    PG8_STAGE(PG8_SB(0, 0), cB, voffB); PG8_STAGE(PG8_SB(0, 1), cB + hstepB, voffB); PG8_STAGE(PG8_SA(0, 0), cA, voffA); PG8_STAGE(PG8_SA(0, 1), cA + hstepA, voffA);
    if (wr == 1) PG8_BAR;
    PG8_WAIT_V(2); PG8_BAR;
    PG8_STAGE(PG8_SB(1, 0), cB + kstep, voffB); PG8_STAGE(PG8_SA(1, 0), cA + kstep, voffA); PG8_STAGE(PG8_SB(1, 1), cB + hstepB + kstep, voffB);
    PG8_WAIT_V(6); PG8_BAR;
    for (;;) {
        const bool has_next = S.next(ui + 1, nxt);
        const char* nA = has_next ? (const char*)g.A + ((size_t)nxt.arow * g.lda + nxt.kofs) * 2 : cA; const char* nB = has_next ? (const char*)g.Bt + ((size_t)nxt.brow * g.ldb + nxt.kofs) * 2 : cB;
        for (int t = 0; t < nt; t += 2) {
            const bool last = (t == nt - 2);
            const char* a1 = cA + (size_t)(t + 1) * kstep;
            const char* a2 = last ? nA : cA + (size_t)(t + 2) * kstep; const char* b2 = last ? nB : cB + (size_t)(t + 2) * kstep;
            const char* a3 = a2 + kstep; const char* b3 = b2 + kstep;
            PG8_LDB(B0, 0, 0); PG8_LDB(B1, 0, 1); PG8_SCHED; PG8_LDA(At, 0, 0); PG8_STAGE(PG8_SA(1, 1), a1 + hstepA, voffA);
            PG8_WAIT_V(8); PG8_WAIT_L(0); PG8_BAR; PG8_MMA(0, 0, At, B0); PG8_MMA(0, 1, At, B1); PG8_BAR; PG8_SCHED;
            PG8_LDA(At, 0, 1); PG8_STAGE(PG8_SB(0, 0), b2, voffB); PG8_STAGE(PG8_SB(0, 1), b2 + hstepB, voffB); PG8_STAGE(PG8_SA(0, 0), a2, voffA);
            PG8_WAIT_V(8); PG8_WAIT_L(0); PG8_BAR; PG8_MMA(1, 0, At, B0); PG8_MMA(1, 1, At, B1); PG8_BAR; PG8_SCHED;
            PG8_LDB(B0, 1, 0); PG8_LDB(B1, 1, 1); PG8_SCHED; PG8_LDA(At, 1, 0); PG8_STAGE(PG8_SA(0, 1), a2 + hstepA, voffA);
            PG8_WAIT_V(8); PG8_WAIT_L(0); PG8_BAR; PG8_MMA(0, 0, At, B0); PG8_MMA(0, 1, At, B1); PG8_BAR; PG8_SCHED;
            PG8_LDA(At, 1, 1); PG8_STAGE(PG8_SB(1, 0), b3, voffB); PG8_STAGE(PG8_SB(1, 1), b3 + hstepB, voffB); PG8_STAGE(PG8_SA(1, 0), a3, voffA);
            PG8_WAIT_V(8); PG8_WAIT_L(0); PG8_BAR; PG8_MMA(1, 0, At, B0); PG8_MMA(1, 1, At, B1); PG8_BAR; PG8_SCHED;
        }
        if constexpr (ALIGN_EPI) { if (wr == 0) PG8_BAR; }
        if constexpr (!Epi::AFTER_DRAIN) { E(acc, cur, wr, wc, fr, fq, xlds, wid, lane); }
        if (!has_next) break;
#pragma unroll
        for (int a = 0; a < 2; ++a)
#pragma unroll
            for (int b = 0; b < 2; ++b)
#pragma unroll
                for (int m = 0; m < 4; ++m)
#pragma unroll
                    for (int n = 0; n < 2; ++n) acc[a][b][m][n] = (f32x4){0.f, 0.f, 0.f, 0.f};
        cur = nxt; cA = nA; cB = nB; ++ui;
        if constexpr (ALIGN_EPI) { if (wr == 1) PG8_BAR; }
    }
    PG8_WAIT_V(0);
    if constexpr (!ALIGN_EPI) { if (wr == 0) PG8_BAR; }
    PG8_BAR;
    if constexpr (Epi::AFTER_DRAIN) { E.fused(acc, cur, wr, wc, fr, fq, lds, wid, lane); }
#undef PG8_SA
#undef PG8_SB
#undef PG8_STAGE
#undef PG8_LDA
#undef PG8_LDB
#undef PG8_MMA
#undef PG8_WAIT_V
#undef PG8_WAIT_L
#undef PG8_BAR
#undef PG8_SCHED
}

typedef const f32x4 (&AccRef)[2][2][4][2];
#define PG8_EPI_ARGS AccRef acc, const Unit& u, int wr, int wc, int fr, int fq, PG8_LAS unsigned char* xlds, int wid, int lane

struct EpiInProj {
    static constexpr bool PERM = true, AFTER_DRAIN = false;
    bf16_t *U, *YS, *DK, *DV, *SK, *SV; const float *cs, *sn;
    __device__ __forceinline__ void operator()(PG8_EPI_ARGS) const {
        const int pn = u.pn, row0 = u.pm * BM + wr * 64 + fr;
        int kind, ld, d0, d1; bf16_t* base;
        const float qs = (pn == 6 || pn == 7) ? 0.125f * 1.4426950408889634f : 1.0f;
        if (pn < 4)       { kind = 0; base = U;  ld = 512;  d0 = 128 * pn + 32 * wc + 8 * fq; d1 = 0; }
        else if (pn < 6)  { kind = 1; base = YS; ld = 1536; d0 = (pn - 4) * 256 + 32 * wc + 8 * fq; d1 = d0 + 128; }
        else if (pn < 8)  { kind = 2; base = YS; ld = 1536; d0 = 512 + (4 * (pn - 6) + wc) * 64 + 8 * fq; d1 = d0 + 32; }
        else if (pn < 10) { kind = 2; base = DK; ld = 512;  d0 = (4 * (pn - 8) + wc) * 64 + 8 * fq; d1 = d0 + 32; }
        else if (pn < 12) { kind = 1; base = DV; ld = 512;  d0 = (pn - 10) * 256 + 32 * wc + 8 * fq; d1 = d0 + 128; }
        else if (pn < 14) { kind = 2; base = YS; ld = 1536; d0 = 1024 + (4 * (pn - 12) + wc) * 64 + 8 * fq; d1 = d0 + 32; }
        else if (wc < 2)  { kind = 2; base = SK; ld = 128;  d0 = wc * 64 + 8 * fq; d1 = d0 + 32; }
        else              { kind = 1; base = SV; ld = 128;  d0 = 32 * (wc - 2) + 8 * fq; d1 = d0 + 64; }
#pragma unroll
        for (int ai = 0; ai < 2; ++ai)
#pragma unroll
            for (int m = 0; m < 4; ++m) {
                const int row = row0 + ai * HALF + m * 16;
                bf16_t* rp = base + (size_t)row * ld;
                const f32x4 x0a = acc[ai][0][m][0], x0b = acc[ai][0][m][1], x1a = acc[ai][1][m][0], x1b = acc[ai][1][m][1];
                if (kind == 0) { *(u32x4*)(rp + d0) = pack8(x0a * x1a, x0b * x1b); }
                else if (kind == 1) { *(u32x4*)(rp + d0) = pack8(x0a, x0b); *(u32x4*)(rp + d1) = pack8(x1a, x1b); }
                else {
                    const f32x4 ca = *(const f32x4*)(cs + (size_t)row * 32 + 8 * fq), cb = *(const f32x4*)(cs + (size_t)row * 32 + 8 * fq + 4);
                    const f32x4 sa = *(const f32x4*)(sn + (size_t)row * 32 + 8 * fq), sb = *(const f32x4*)(sn + (size_t)row * 32 + 8 * fq + 4);
                    *(u32x4*)(rp + d0) = pack8((x0a * ca - x1a * sa) * qs, (x0b * cb - x1b * sb) * qs);
                    *(u32x4*)(rp + d1) = pack8((x1a * ca + x0a * sa) * qs, (x1b * cb + x0b * sb) * qs);
                }
            }
    }
};

struct EpiGates {
    static constexpr bool PERM = true, AFTER_DRAIN = false;
    bf16_t* G; const float* bias;
    __device__ __forceinline__ void operator()(PG8_EPI_ARGS) const {
        const int row0 = u.pm * BM + wr * 64 + fr, col0 = u.pn * BM + wc * 32 + 8 * fq;
        f32x4 bv[2][2];
#pragma unroll
        for (int bj = 0; bj < 2; ++bj)
#pragma unroll
            for (int n = 0; n < 2; ++n) bv[bj][n] = *(const f32x4*)(bias + col0 + bj * HALF + 4 * n);
#pragma unroll
        for (int ai = 0; ai < 2; ++ai)
#pragma unroll
            for (int m = 0; m < 4; ++m) { bf16_t* rp = G + (size_t)(row0 + ai * HALF + m * 16) * 3072 + col0;
#pragma unroll
                for (int bj = 0; bj < 2; ++bj) { f32x4 v[2];
#pragma unroll
                    for (int n = 0; n < 2; ++n) { const f32x4 x = acc[ai][bj][m][n] + bv[bj][n];
#pragma unroll
                        for (int e = 0; e < 4; ++e) v[n][e] = __builtin_amdgcn_rcpf(1.0f + __builtin_amdgcn_exp2f(x[e] * -1.4426950408889634f)); }
                    *(u32x4*)(rp + bj * HALF) = pack8(v[0], v[1]); } }
    }
};

struct EpiBranch {
    static constexpr bool PERM = true, AFTER_DRAIN = false;
    bf16_t* O; const bf16_t* GT;
    __device__ __forceinline__ void operator()(PG8_EPI_ARGS) const {
        const int row0 = u.pm * BM + wr * 64 + fr, col0 = u.pn * BM + wc * 32 + 8 * fq, seg = u.seg;
#pragma unroll
        for (int ai = 0; ai < 2; ++ai)
#pragma unroll
            for (int m = 0; m < 4; ++m) { const int row = row0 + ai * HALF + m * 16;
#pragma unroll
                for (int bj = 0; bj < 2; ++bj) {
                    const u32x4 gw = *(const u32x4*)(GT + (size_t)row * 3072 + seg * 1024 + col0 + bj * HALF);
                    f32x4 ga, gb; unpack8(gw, ga, gb);
                    f32x4 va = ga * acc[ai][bj][m][0], vb = gb * acc[ai][bj][m][1];
                    bf16_t* op = O + (size_t)row * 1024 + col0 + bj * HALF;
                    if (seg > 0) { const u32x4 pw = *(const u32x4*)op; f32x4 pa, pb; unpack8(pw, pa, pb); va += pa; vb += pb; }
                    *(u32x4*)op = pack8(va, vb); } }
    }
};

struct EpiResid {
    static constexpr bool PERM = true, AFTER_DRAIN = false;
    float* H; float alpha;
    __device__ __forceinline__ void operator()(PG8_EPI_ARGS) const {
        const int row0 = u.pm * BM + wr * 64 + fr, col0 = u.pn * BM + wc * 32 + 8 * fq;
#pragma unroll
        for (int ai = 0; ai < 2; ++ai)
#pragma unroll
            for (int m = 0; m < 4; ++m) { float* rp = H + (size_t)(row0 + ai * HALF + m * 16) * 1024 + col0;
#pragma unroll
                for (int bj = 0; bj < 2; ++bj)
#pragma unroll
                    for (int n = 0; n < 2; ++n) { f32x4* p = (f32x4*)(rp + bj * HALF + 4 * n); const f32x4 h = *p; *p = h * alpha + acc[ai][bj][m][n]; } }
    }
};

__device__ __forceinline__ float dpp_ror1(float v)  { return __int_as_float(__builtin_amdgcn_update_dpp(0, __float_as_int(v), 0x121, 0xf, 0xf, false)); }
__device__ __forceinline__ float dpp_ror15(float v) { return __int_as_float(__builtin_amdgcn_update_dpp(0, __float_as_int(v), 0x12F, 0xf, 0xf, false)); }
__device__ __forceinline__ f32x4 ror1_4(f32x4 v)  { return (f32x4){dpp_ror1(v[0]), dpp_ror1(v[1]), dpp_ror1(v[2]), dpp_ror1(v[3])}; }
__device__ __forceinline__ f32x4 ror15_4(f32x4 v) { return (f32x4){dpp_ror15(v[0]), dpp_ror15(v[1]), dpp_ror15(v[2]), dpp_ror15(v[3])}; }
struct EpiUpConv {
    static constexpr bool PERM = true, AFTER_DRAIN = false;
    bf16_t* ACT; const float* cw;
    static constexpr int S = 16384;
    __device__ __forceinline__ void operator()(AccRef acc, const Unit& u, int wr_, int wc_, int fr_, int fq_, PG8_LAS unsigned char* xlds, int wid_, int lane_) const {
        int ln; asm volatile("v_mbcnt_lo_u32_b32 %0, -1, 0\n\tv_mbcnt_hi_u32_b32 %0, -1, %0" : "=v"(ln));
        int wid = wid_; asm volatile("" : "+s"(wid));
        const int fr = ln & 15, fq = ln >> 4, wr = wid >> 2, wc = wid & 3;
        (void)wr_; (void)wc_; (void)fr_; (void)fq_; (void)lane_;
        PG8_LAS f32x4* X = (PG8_LAS f32x4*)xlds;
        if (fr == 0) {
#pragma unroll
            for (int ai = 0; ai < 2; ++ai)
#pragma unroll
                for (int bj = 0; bj < 2; ++bj)
#pragma unroll
                    for (int n = 0; n < 2; ++n) X[((((wid * 2 + ai) * 2 + 0) * 2 + bj) * 2 + n) * 4 + fq] = acc[ai][bj][0][n];
        }
        if (fr == 15) {
#pragma unroll
            for (int ai = 0; ai < 2; ++ai)
#pragma unroll
                for (int bj = 0; bj < 2; ++bj)
#pragma unroll
                    for (int n = 0; n < 2; ++n) X[((((wid * 2 + ai) * 2 + 1) * 2 + bj) * 2 + n) * 4 + fq] = acc[ai][bj][3][n];
        }
        asm volatile("s_waitcnt lgkmcnt(0)" ::: "memory"); __builtin_amdgcn_s_barrier(); asm volatile("" ::: "memory");
        const int pw = (1 - wr) * 4 + wc;
        const bool f0 = (fr == 0), f15 = (fr == 15);
        const int ubr = S - 254 * u.pm - 1; const unsigned ub = (unsigned)(ubr < 253 ? ubr : 253);
#pragma unroll
        for (int ai = 0; ai < 2; ++ai) {
            const int aip = (ai == 0) ? 0 : wr, ain = (ai == 0) ? wr : 1;
            const bool pvalid = !(ai == 0 && wr == 0), nvalid = !(ai == 1 && wr == 1);
#pragma unroll
            for (int n = 0; n < 2; ++n) {
                asm volatile("" ::: "memory");
                int zr = 0; asm volatile("" : "+v"(zr));
                const int colg = 128 * u.pn + 32 * wc + 8 * fq + 4 * n;
                const float* wp = cw + colg;
                const f32x4 g0 = *(const f32x4*)(wp), g1 = *(const f32x4*)(wp + 5632), g2 = *(const f32x4*)(wp + 2 * 5632);
                const f32x4 u0 = *(const f32x4*)(wp + 2816), u1 = *(const f32x4*)(wp + 2816 + 5632), u2 = *(const f32x4*)(wp + 2816 + 2 * 5632);
                f32x4 hpg = X[((((pw * 2 + aip) * 2 + 1) * 2 + 0) * 2 + n) * 4 + fq], hpu = X[((((pw * 2 + aip) * 2 + 1) * 2 + 1) * 2 + n) * 4 + fq];
                f32x4 hng = X[((((pw * 2 + ain) * 2 + 0) * 2 + 0) * 2 + n) * 4 + fq], hnu = X[((((pw * 2 + ain) * 2 + 0) * 2 + 1) * 2 + n) * 4 + fq];
                if (!pvalid) { hpg = (f32x4){0.f, 0.f, 0.f, 0.f}; hpu = hpg; }
                if (!nvalid) { hng = (f32x4){0.f, 0.f, 0.f, 0.f}; hnu = hng; }
                f32x4 rpg = hpg, rpu = hpu, rcg = ror15_4(acc[ai][0][0][n]), rcu = ror15_4(acc[ai][1][0][n]);
#pragma unroll
                for (int m = 0; m < 4; ++m) {
                    const f32x4 xg = acc[ai][0][m][n], xu = acc[ai][1][m][n];
                    const f32x4 rrg = ror1_4(xg), rru = ror1_4(xu);
                    f32x4 rng = hng, rnu = hnu; if (m < 3) { rng = ror15_4(acc[ai][0][m + 1][n]); rnu = ror15_4(acc[ai][1][m + 1][n]); }
                    f32x4 pg, ng, pu, nu;
#pragma unroll
                    for (int e = 0; e < 4; ++e) { pg[e] = f0 ? rpg[e] : rrg[e]; ng[e] = f15 ? rng[e] : rcg[e]; pu[e] = f0 ? rpu[e] : rru[e]; nu[e] = f15 ? rnu[e] : rcu[e]; }
                    const f32x4 yg = g0 * pg + g1 * xg + g2 * ng, yu = u0 * pu + u1 * xu + u2 * nu;
                    rpg = rrg; rpu = rru; rcg = rng; rcu = rnu;
                    const int r = ai * HALF + wr * 64 + m * 16 + fr + zr, grow = 254 * u.pm - 1 + r;
                    const f32x4 a = gelu4(yg) * yu;
                    u32x2 w; w.x = cvt_pk_bf16(a[0], a[1]); w.y = cvt_pk_bf16(a[2], a[3]);
                    if ((unsigned)(r - 1) <= ub) *(u32x2*)(ACT + (size_t)grow * 2816 + colg) = w;
                }
            }
        }
    }
};
}

namespace att {
typedef unsigned short bf16_t;
using bf16x8 = __attribute__((ext_vector_type(8))) short;
using s16x4  = __attribute__((ext_vector_type(4))) short;
using f32x16 = __attribute__((ext_vector_type(16))) float;
using u32x4  = __attribute__((ext_vector_type(4))) unsigned;
using u32x2  = __attribute__((ext_vector_type(2))) unsigned;
constexpr int NW = 8, QBLK = 32, KVBLK = 64;
constexpr int SHM_V = KVBLK * 128 * 2, SHM_K = KVBLK * 64 * 2, SHM_ATTN = 2 * SHM_V + 2 * SHM_K;
constexpr float SCALE = 0.125f;
constexpr float CEXP = SCALE * 1.4426950408889634f;
constexpr float THR = 8.f;
#define KSWZ64(row, cb) ((row) * 128 + ((cb) ^ ((((row) >> 1) & 7) << 4)))
#define ATT_SBAR() __builtin_amdgcn_sched_barrier(0)
__device__ __forceinline__ int crow(int r, int hi) { return (r & 3) + 8 * (r >> 2) + 4 * hi; }
__device__ __forceinline__ unsigned cvtpk(float lo, float hi) { return pg8::cvt_pk_bf16(lo, hi); }

template <bool MASK>
__device__ __forceinline__ void partialSM(f32x16& p0, f32x16& p1, float& m_reg, float& mn, float& alpha, int dq, int hi, int win) {
  if (MASK) {
#pragma unroll
    for (int r = 0; r < 16; ++r) { const int d0 = dq + crow(r, hi), d1 = d0 + 32;
      if (d0 > win || d0 < -win) p0[r] = -INFINITY; if (d1 > win || d1 < -win) p1[r] = -INFINITY; }
  }
  float pmax = p0[0];
#pragma unroll
  for (int r = 1; r < 16; ++r) pmax = fmaxf(pmax, p0[r]);
#pragma unroll
  for (int r = 0; r < 16; ++r) pmax = fmaxf(pmax, p1[r]);
  { auto rr = __builtin_amdgcn_permlane32_swap(__float_as_uint(pmax), __float_as_uint(pmax), false, false);
    pmax = fmaxf(__uint_as_float(rr[0]), __uint_as_float(rr[1])); }
  if (__builtin_expect(__all(pmax - m_reg <= THR / SCALE), 1)) { mn = m_reg; alpha = 1.f; }
  else { mn = fmaxf(m_reg, pmax); alpha = __builtin_amdgcn_exp2f((m_reg - mn) * CEXP); m_reg = mn; }
  const float mnC = -mn * CEXP;
#pragma unroll
  for (int r = 0; r < 16; ++r) p0[r] = fmaf(p0[r], CEXP, mnC);
#pragma unroll
  for (int r = 0; r < 16; ++r) p1[r] = fmaf(p1[r], CEXP, mnC);
#pragma unroll
  for (int r = 0; r < 16; ++r) p0[r] = __builtin_amdgcn_exp2f(p0[r]);
}
__device__ __forceinline__ void finishSM(f32x16& p0, f32x16& p1, float alpha, float& l_reg, bf16x8& pa0, bf16x8& pa1, bf16x8& pa2, bf16x8& pa3) {
#pragma unroll
  for (int r = 0; r < 16; ++r) p1[r] = __builtin_amdgcn_exp2f(p1[r]);
  float ps = 0;
#pragma unroll
  for (int r = 0; r < 16; ++r) ps += p0[r];
#pragma unroll
  for (int r = 0; r < 16; ++r) ps += p1[r];
  { auto rr = __builtin_amdgcn_permlane32_swap(__float_as_uint(ps), __float_as_uint(ps), false, false);
    ps = __uint_as_float(rr[0]) + __uint_as_float(rr[1]); }
  l_reg = l_reg * alpha + ps;
#define ATT_PK4(P, BASE, OUT) do { unsigned a0 = cvtpk(P[BASE + 0], P[BASE + 1]), a1 = cvtpk(P[BASE + 2], P[BASE + 3]);   \
    unsigned b0 = cvtpk(P[BASE + 4], P[BASE + 5]), b1 = cvtpk(P[BASE + 6], P[BASE + 7]);                              \
    auto r0 = __builtin_amdgcn_permlane32_swap(a0, b0, false, false); auto r1 = __builtin_amdgcn_permlane32_swap(a1, b1, false, false); \
    u32x4 w = {r0[0], r1[0], r0[1], r1[1]}; OUT = *reinterpret_cast<bf16x8*>(&w); } while (0)
  ATT_PK4(p0, 0, pa0); ATT_PK4(p0, 8, pa1); ATT_PK4(p1, 0, pa2); ATT_PK4(p1, 8, pa3);
#undef ATT_PK4
}
__device__ __forceinline__ void qkt(f32x16& p0, f32x16& p1, const char* Ks, const bf16x8* qr, int r32, int hi) {
  p0 = f32x16{}; p1 = f32x16{};
#pragma unroll
  for (int d0 = 0; d0 < 4; ++d0) { const int cb = (d0 * 16 + hi * 8) * 2;
    const bf16x8 b0 = *reinterpret_cast<const bf16x8*>(Ks + KSWZ64(r32, cb));
    const bf16x8 b1 = *reinterpret_cast<const bf16x8*>(Ks + KSWZ64(32 + r32, cb));
    p0 = __builtin_amdgcn_mfma_f32_32x32x16_bf16(b0, qr[d0], p0, 0, 0, 0);
    p1 = __builtin_amdgcn_mfma_f32_32x32x16_bf16(b1, qr[d0], p1, 0, 0, 0); }
}
__device__ __forceinline__ int v_st(int k, int c) { const int kk = (k & ~0xC) | ((k & 4) << 1) | ((k & 8) >> 1); return ((kk >> 3) * 4 + (c >> 5)) * 512 + ((kk & 7) * 32 + (c & 31)) * 2; }
__device__ __forceinline__ int v_rd_base(int lane) { return ((lane & 3) << 3) | (((lane >> 2) & 3) << 6) | (((lane >> 4) & 1) << 5) | (((lane >> 5) & 1) << 8); }
constexpr int v_rd_off(int d0, int ks, int half) { return d0 * 512 + ks * 4096 + half * 2048; }
template <int OFF> __device__ __forceinline__ s16x4 tr_read(int vb) {
  s16x4 r; asm volatile("ds_read_b64_tr_b16 %0, %1 offset:%2" : "=&v"(r) : "v"(vb), "i"(OFF) : "memory"); return r;
}
template <int D0> __device__ __forceinline__ void pv_one(f32x16& od, int vb, bf16x8 pa0, bf16x8 pa1, bf16x8 pa2, bf16x8 pa3) {
  const s16x4 l0 = tr_read<v_rd_off(D0, 0, 0)>(vb), h0 = tr_read<v_rd_off(D0, 0, 1)>(vb), l1 = tr_read<v_rd_off(D0, 1, 0)>(vb), h1 = tr_read<v_rd_off(D0, 1, 1)>(vb);
  const s16x4 l2 = tr_read<v_rd_off(D0, 2, 0)>(vb), h2 = tr_read<v_rd_off(D0, 2, 1)>(vb), l3 = tr_read<v_rd_off(D0, 3, 0)>(vb), h3 = tr_read<v_rd_off(D0, 3, 1)>(vb);
  { s16x4 a0 = l0, a1 = h0, a2 = l1, a3 = h1, a4 = l2, a5 = h2, a6 = l3, a7 = h3;
    asm volatile("s_waitcnt lgkmcnt(0)" : "+v"(a0), "+v"(a1), "+v"(a2), "+v"(a3), "+v"(a4), "+v"(a5), "+v"(a6), "+v"(a7) :: "memory");
    od = __builtin_amdgcn_mfma_f32_32x32x16_bf16((bf16x8){a0[0], a0[1], a0[2], a0[3], a1[0], a1[1], a1[2], a1[3]}, pa0, od, 0, 0, 0);
    od = __builtin_amdgcn_mfma_f32_32x32x16_bf16((bf16x8){a2[0], a2[1], a2[2], a2[3], a3[0], a3[1], a3[2], a3[3]}, pa1, od, 0, 0, 0);
    od = __builtin_amdgcn_mfma_f32_32x32x16_bf16((bf16x8){a4[0], a4[1], a4[2], a4[3], a5[0], a5[1], a5[2], a5[3]}, pa2, od, 0, 0, 0);
    od = __builtin_amdgcn_mfma_f32_32x32x16_bf16((bf16x8){a6[0], a6[1], a6[2], a6[3], a7[0], a7[1], a7[2], a7[3]}, pa3, od, 0, 0, 0);
    return; }
#define ATT_PK(L, H) (bf16x8){L[0], L[1], L[2], L[3], H[0], H[1], H[2], H[3]}
  od = __builtin_amdgcn_mfma_f32_32x32x16_bf16(ATT_PK(l0, h0), pa0, od, 0, 0, 0);
  od = __builtin_amdgcn_mfma_f32_32x32x16_bf16(ATT_PK(l1, h1), pa1, od, 0, 0, 0);
  od = __builtin_amdgcn_mfma_f32_32x32x16_bf16(ATT_PK(l2, h2), pa2, od, 0, 0, 0);
  od = __builtin_amdgcn_mfma_f32_32x32x16_bf16(ATT_PK(l3, h3), pa3, od, 0, 0, 0);
#undef ATT_PK
}
template <int DV> __device__ __forceinline__ void pv_all(f32x16* o, int vb, bf16x8 pa0, bf16x8 pa1, bf16x8 pa2, bf16x8 pa3) {
  pv_one<0>(o[0], vb, pa0, pa1, pa2, pa3); pv_one<1>(o[1], vb, pa0, pa1, pa2, pa3);
  if constexpr (DV == 128) { pv_one<2>(o[2], vb, pa0, pa1, pa2, pa3); pv_one<3>(o[3], vb, pa0, pa1, pa2, pa3); }
}

__device__ __forceinline__ void glds16(const void* g, unsigned lds_base) {
  unsigned sv; asm volatile("s_mov_b32 %0, m0\n\ts_mov_b32 m0, %2\n\ts_nop 0\n\tglobal_load_lds_dwordx4 %1, off\n\ts_mov_b32 m0, %0" : "=&s"(sv) : "v"(g), "s"(lds_base) : "memory"); }
#define ATT_WAIT_BAR(N) asm volatile("s_waitcnt vmcnt(" #N ") lgkmcnt(0)\n\ts_barrier" ::: "memory")
constexpr int SLOT_K = SHM_K, SLOT_V = SHM_V, NSLOT = 3;
constexpr int LDS_KR = 0, LDS_VR = NSLOT * SLOT_K, SHM_ATTN2 = NSLOT * (SLOT_K + SLOT_V);

template <int DV, bool MASK, int ldk, int ldv>
__device__ __forceinline__ void attn_core(const int tid, const bf16_t* __restrict__ Qw, const bf16_t* __restrict__ Kh, const bf16_t* __restrict__ Vh, int NT,
                                          float m_init, float l_init, int dq0, int win, char* lds, f32x16 (&o)[DV / 32], float& l_out) {
  constexpr int NV = DV / 64;
  const int lane = tid & 63, r32 = lane & 31, hi = lane >> 5; const int wid = __builtin_amdgcn_readfirstlane(tid >> 6);
  const unsigned lds0 = (unsigned)(uintptr_t)lds;
  float m_reg = m_init, l_reg = l_init;
#pragma unroll
  for (int d = 0; d < DV / 32; ++d) o[d] = f32x16{};
  const int krow = 8 * wid + (lane >> 3);
  const bf16_t* ksrc = Kh + (size_t)krow * ldk + (((lane & 7) ^ ((krow >> 1) & 7)) * 8);
  const int vp = (DV == 128) ? wid : 2 * wid;
  const int vkk = 8 * (vp >> 1) + ((lane & 31) >> 2), vk = (vkk & ~0xC) | ((vkk & 4) << 1) | ((vkk & 8) >> 1);
  const int vc = 32 * (2 * (vp & 1) + (lane >> 5)) + 8 * (lane & 3);
  const bf16_t* vsrc = Vh + (size_t)vk * ldv + vc;
  const unsigned kdst = lds0 + LDS_KR + wid * 1024, vdst = lds0 + LDS_VR + vp * 1024;
#define ATT_DMA_K(t, slot) glds16(ksrc + (size_t)(t) * KVBLK * ldk, (unsigned)__builtin_amdgcn_readfirstlane(kdst + (slot) * SLOT_K))
#define ATT_DMA_V(t, slot) do { glds16(vsrc + (size_t)(t) * KVBLK * ldv, (unsigned)__builtin_amdgcn_readfirstlane(vdst + (slot) * SLOT_V)); \
    if constexpr (DV == 128) glds16(vsrc + (size_t)((t) * KVBLK + 32) * ldv, (unsigned)__builtin_amdgcn_readfirstlane(vdst + (slot) * SLOT_V + 8192)); } while (0)
  ATT_DMA_K(0, 0); ATT_DMA_V(0, 0); ATT_DMA_K(1, 1);
  bf16x8 qr[4];
#pragma unroll
  for (int d0 = 0; d0 < 4; ++d0) qr[d0] = *reinterpret_cast<const bf16x8*>(Qw + d0 * 16);
  const int vb0 = (int)lds0 + LDS_VR + v_rd_base(lane);
  const char* K_lds = lds + LDS_KR;
#define ATT_RESC(a) do { if (__any((a) < 1.f)) { _Pragma("unroll") for (int d = 0; d < DV / 32; ++d) _Pragma("unroll") for (int r = 0; r < 16; ++r) o[d][r] *= (a); } } while (0)
  f32x16 pA0, pA1, pB0, pB1; float mnA, mnB, alA, alB; bf16x8 pa0, pa1, pa2, pa3;
  int s_prev = 0, s_cur = 0, s_next = 1;
#define ATT_ROT() do { s_prev = s_cur; s_cur = s_next; s_next = (s_next == NSLOT - 1) ? 0 : s_next + 1; } while (0)
  if constexpr (NV == 2) ATT_WAIT_BAR(3); else ATT_WAIT_BAR(2);
  { const int s2 = 2; ATT_DMA_K(2, s2); ATT_DMA_V(1, s_next); }
  qkt(pA0, pA1, K_lds, qr, r32, hi); partialSM<MASK>(pA0, pA1, m_reg, mnA, alA, dq0, hi, win);
  if constexpr (NV == 2) ATT_WAIT_BAR(3); else ATT_WAIT_BAR(2);
  ATT_ROT();
#define ATT_STEP(C0, C1, mnC_, alC_, P0, P1, alP_, j, GK, GV, NWAIT) do { \
    if (GK) { const int s2_ = (s_next == NSLOT - 1) ? 0 : s_next + 1; ATT_DMA_K((j) + 2, s2_); } \
    if (GV) { ATT_DMA_V((j) + 1, s_next); } \
    ATT_SBAR(); qkt(C0, C1, K_lds + s_cur * SLOT_K, qr, r32, hi); \
    finishSM(P0, P1, alP_, l_reg, pa0, pa1, pa2, pa3); ATT_SBAR(); \
    pv_all<DV>(o, vb0 + s_prev * SLOT_V, pa0, pa1, pa2, pa3); partialSM<MASK>(C0, C1, m_reg, mnC_, alC_, dq0 + (j) * KVBLK, hi, win); \
    ATT_RESC(alC_); \
    ATT_WAIT_BAR(NWAIT); ATT_ROT(); } while (0)
  int j = 1;
  if constexpr (NV == 2) {
    for (; j + 3 < NT; j += 2) { ATT_STEP(pB0, pB1, mnB, alB, pA0, pA1, alA, j, true, true, 3); ATT_STEP(pA0, pA1, mnA, alA, pB0, pB1, alB, j + 1, true, true, 3); }
    ATT_STEP(pB0, pB1, mnB, alB, pA0, pA1, alA, j, true, true, 3);
    ATT_STEP(pA0, pA1, mnA, alA, pB0, pB1, alB, j + 1, false, true, 2);
    ATT_STEP(pB0, pB1, mnB, alB, pA0, pA1, alA, j + 2, false, false, 0);
  } else {
    for (; j + 3 < NT; j += 2) { ATT_STEP(pB0, pB1, mnB, alB, pA0, pA1, alA, j, true, true, 2); ATT_STEP(pA0, pA1, mnA, alA, pB0, pB1, alB, j + 1, true, true, 2); }
    ATT_STEP(pB0, pB1, mnB, alB, pA0, pA1, alA, j, true, true, 2);
    ATT_STEP(pA0, pA1, mnA, alA, pB0, pB1, alB, j + 1, false, true, 1);
    ATT_STEP(pB0, pB1, mnB, alB, pA0, pA1, alA, j + 2, false, false, 0);
  }
  finishSM(pB0, pB1, alB, l_reg, pa0, pa1, pa2, pa3); ATT_SBAR();
  pv_all<DV>(o, vb0 + s_prev * SLOT_V, pa0, pa1, pa2, pa3);
  l_out = l_reg;
#undef ATT_DMA_K
#undef ATT_DMA_V
#undef ATT_RESC
#undef ATT_ROT
#undef ATT_STEP
}

typedef __attribute__((address_space(3))) const char* lds_cptr;
typedef short v4i16_t __attribute__((ext_vector_type(4)));
__device__ __forceinline__ float max3f(float a, float b, float c) { return __builtin_fmaxf(__builtin_fmaxf(a, b), c); }
__device__ __forceinline__ void kload2(bf16x8* kf, lds_cptr kp, int j) { kf[2 * j] = *(const __attribute__((address_space(3))) bf16x8*)(kp + j * 2048); kf[2 * j + 1] = *(const __attribute__((address_space(3))) bf16x8*)(kp + j * 2048 + 512); }
__device__ __forceinline__ s16x4 vtr(lds_cptr p) { return __builtin_bit_cast(s16x4, __builtin_amdgcn_ds_read_tr16_b64_v4i16((__attribute__((address_space(3))) v4i16_t*)p)); }
constexpr int DSLOT_K = 8192, DSLOT_V = 16384, D_LDS_K = 0, D_LDS_V = 3 * DSLOT_K, SHM_DIFF = 3 * (DSLOT_K + DSLOT_V);
#define DA_PIN(x) asm volatile("" : "+v"(x))
template <int ldk, int ldv, int THRL>
__device__ __forceinline__ void attn_diff_core(const int tid, const bf16_t* __restrict__ Qw, const bf16_t* __restrict__ Kh, const bf16_t* __restrict__ Vh, const int NT, char* shm, f32x16 (&o)[4], float& l_out) {
  const int lane = tid & 63, r32 = lane & 31, hi = lane >> 5; const int wid = __builtin_amdgcn_readfirstlane(tid >> 6);
  const unsigned lds0 = (unsigned)(uintptr_t)shm;
  const bf16_t* ksrc = Kh + (size_t)lane * ldk + wid * 8;
  const bf16_t* vsrc = Vh + (size_t)(16 * (wid & 3) + (lane >> 2)) * ldv + (wid >> 2) * 32 + (lane & 3) * 8;
  const unsigned kdst = lds0 + D_LDS_K + wid * 1024, vdst = lds0 + D_LDS_V + wid * 1024;
#define DA_DMA_K(t, slot) glds16(ksrc + (size_t)(t) * KVBLK * ldk, (unsigned)__builtin_amdgcn_readfirstlane(kdst + (slot)))
#define DA_DMA_V(t, slot) do { glds16(vsrc + (size_t)(t) * KVBLK * ldv, (unsigned)__builtin_amdgcn_readfirstlane(vdst + 2 * (slot))); \
    glds16(vsrc + (size_t)(t) * KVBLK * ldv + 64, (unsigned)__builtin_amdgcn_readfirstlane(vdst + 2 * (slot) + 8192)); } while (0)
  const lds_cptr shm3 = (lds_cptr)shm; const lds_cptr kp0 = shm3 + D_LDS_K + hi * 1024 + r32 * 16;
  const lds_cptr vp0 = shm3 + D_LDS_V + ((lane >> 4) & 1) * 32 + (lane & 3) * 8 + (4 * hi + ((lane & 15) >> 2)) * 64;
  bf16x8 kf[8];
  DA_DMA_K(0, 0); DA_DMA_V(0, 0); DA_DMA_K(1, DSLOT_K);
  bf16x8 qr[4];
#pragma unroll
  for (int d0 = 0; d0 < 4; ++d0) qr[d0] = *reinterpret_cast<const bf16x8*>(Qw + d0 * 16);
  float mhat = -1e30f, l_reg = 0.f, fres = 1.f; bool resc = false;
#pragma unroll
  for (int d = 0; d < 4; ++d) o[d] = f32x16{};
  const f32x16 zero16 = f32x16{};
  f32x16 pA0, pA1, pB0, pB1;
  int sl_prev = 0, sl_cur = 0, sl_next = DSLOT_K;
#define DA_ROT() do { sl_prev = sl_cur; sl_cur = sl_next; sl_next = (sl_next == 2 * DSLOT_K) ? 0 : sl_next + DSLOT_K; } while (0)
#define DA_RESC() do { if (resc) { _Pragma("unroll") for (int d_ = 0; d_ < 4; ++d_) _Pragma("unroll") for (int r = 0; r < 16; ++r) o[d_][r] *= fres; } } while (0)
  DA_DMA_K(2, 2 * DSLOT_K);
  ATT_WAIT_BAR(4);
  { lds_cptr kp = kp0;
#pragma unroll
    for (int j = 0; j < 4; ++j) kload2(kf, kp, j); }
  pA0 = __builtin_amdgcn_mfma_f32_32x32x16_bf16(kf[0], qr[0], zero16, 0, 0, 0); pA1 = __builtin_amdgcn_mfma_f32_32x32x16_bf16(kf[1], qr[0], zero16, 0, 0, 0);
  pA0 = __builtin_amdgcn_mfma_f32_32x32x16_bf16(kf[2], qr[1], pA0, 0, 0, 0);    pA1 = __builtin_amdgcn_mfma_f32_32x32x16_bf16(kf[3], qr[1], pA1, 0, 0, 0);
  pA0 = __builtin_amdgcn_mfma_f32_32x32x16_bf16(kf[4], qr[2], pA0, 0, 0, 0);    pA1 = __builtin_amdgcn_mfma_f32_32x32x16_bf16(kf[5], qr[2], pA1, 0, 0, 0);
  pA0 = __builtin_amdgcn_mfma_f32_32x32x16_bf16(kf[6], qr[3], pA0, 0, 0, 0);    pA1 = __builtin_amdgcn_mfma_f32_32x32x16_bf16(kf[7], qr[3], pA1, 0, 0, 0);
  { float a = max3f(pA0[0], pA0[1], pA1[0]), b = max3f(pA0[2], pA0[3], pA1[1]); a = max3f(a, pA1[2], pA1[3]);
#pragma unroll
    for (int r = 4; r < 16; r += 4) { a = max3f(a, pA0[r], pA0[r + 1]); b = max3f(b, pA0[r + 2], pA0[r + 3]); a = max3f(a, pA1[r], pA1[r + 1]); b = max3f(b, pA1[r + 2], pA1[r + 3]); }
    float rm = __builtin_fmaxf(a, b); { auto rr = __builtin_amdgcn_permlane32_swap(__float_as_uint(rm), __float_as_uint(rm), false, false); rm = __builtin_fmaxf(__uint_as_float(rr[0]), __uint_as_float(rr[1])); }
    mhat = rm;
#pragma unroll
    for (int r = 0; r < 16; ++r) { pA0[r] = __builtin_amdgcn_exp2f(pA0[r] - mhat); pA1[r] = __builtin_amdgcn_exp2f(pA1[r] - mhat); } }
  ATT_WAIT_BAR(0);
  DA_DMA_K(3, 0); DA_DMA_V(1, DSLOT_K);
  DA_ROT();
  { lds_cptr kp = kp0 + sl_cur;
#pragma unroll
    for (int j = 0; j < 4; ++j) kload2(kf, kp, j); }
  ATT_WAIT_BAR(3);
  s16x4 vlo[8], vhi[8]; u32x4 pw0, pw1, pw2, pw3;
#define DA_PKW(P, B) cvtpk(P[B], P[B + 1])
#define DA_PAF(k) __builtin_bit_cast(bf16x8, pw##k)
#define DA_VFR(i) (bf16x8){vlo[i][0], vlo[i][1], vlo[i][2], vlo[i][3], vhi[i][0], vhi[i][1], vhi[i][2], vhi[i][3]}
#define DA_VRD(n) do { vlo[(n) & 7] = vtr(vp_ + (((n) & 3) * 4096 + ((n) >> 2) * 1024)); vhi[(n) & 7] = vtr(vp_ + (((n) & 3) * 4096 + ((n) >> 2) * 1024 + 512)); } while (0)
#define DA_GAPA(n, MF, A0, A1, A2, A3, W0, W1, PW) do { DA_VRD(n); ATT_SBAR(); MF; sacc += A0; sacc += A1; sacc += A2; sacc += A3; DA_PIN(sacc); W0; W1; DA_PIN(PW); ATT_SBAR(); } while (0)
#define DA_EX(X, B) do { X[B] = __builtin_amdgcn_exp2f(X[B] - mhat); X[(B) + 1] = __builtin_amdgcn_exp2f(X[(B) + 1] - mhat); } while (0)
#define DA_GAPB(n, PAFK, X, B, RELOAD, KRD_) do { if (KRD_ >= 0 && GL_) { kload2(kf, kp0 + sl_next, (KRD_ < 0 ? 0 : KRD_)); ATT_SBAR(); } \
    o[(n) & 3] = __builtin_amdgcn_mfma_f32_32x32x16_bf16(DA_VFR((n) & 7), PAFK, o[(n) & 3], 0, 0, 0); \
    if (RELOAD) { DA_VRD((n) + 8); } DA_EX(X, B); DA_PIN(X); ATT_SBAR(); } while (0)
#define DA_STEP(C0, C1, P0, P1, t, GK, GV, GL) do { ATT_SBAR(); \
    const lds_cptr vp_ = vp0 + 2 * sl_prev; const bool GL_ = (GL); \
    float sacc = (P0[0] + P0[1]); \
    DA_GAPA(0, C0 = __builtin_amdgcn_mfma_f32_32x32x16_bf16(kf[0], qr[0], zero16, 0, 0, 0), P0[2], P0[3], P0[4], P0[5],     pw0[0] = DA_PKW(P0, 0), pw0[1] = DA_PKW(P0, 2), pw0); \
    DA_GAPA(1, C1 = __builtin_amdgcn_mfma_f32_32x32x16_bf16(kf[1], qr[0], zero16, 0, 0, 0), P0[6], P0[7], P0[8], P0[9],     pw0[2] = DA_PKW(P0, 4), pw0[3] = DA_PKW(P0, 6), pw0); \
    DA_GAPA(2, C0 = __builtin_amdgcn_mfma_f32_32x32x16_bf16(kf[2], qr[1], C0, 0, 0, 0),     P0[10], P0[11], P0[12], P0[13], pw1[0] = DA_PKW(P0, 8), pw1[1] = DA_PKW(P0, 10), pw1); \
    DA_GAPA(3, C1 = __builtin_amdgcn_mfma_f32_32x32x16_bf16(kf[3], qr[1], C1, 0, 0, 0),     P0[14], P0[15], P1[0], P1[1],   pw1[2] = DA_PKW(P0, 12), pw1[3] = DA_PKW(P0, 14), pw1); \
    DA_GAPA(4, C0 = __builtin_amdgcn_mfma_f32_32x32x16_bf16(kf[4], qr[2], C0, 0, 0, 0),     P1[2], P1[3], P1[4], P1[5],     pw2[0] = DA_PKW(P1, 0), pw2[1] = DA_PKW(P1, 2), pw2); \
    DA_GAPA(5, C1 = __builtin_amdgcn_mfma_f32_32x32x16_bf16(kf[5], qr[2], C1, 0, 0, 0),     P1[6], P1[7], P1[8], P1[9],     pw2[2] = DA_PKW(P1, 4), pw2[3] = DA_PKW(P1, 6), pw2); \
    DA_GAPA(6, C0 = __builtin_amdgcn_mfma_f32_32x32x16_bf16(kf[6], qr[3], C0, 0, 0, 0),     P1[10], P1[11], P1[12], P1[13], pw3[0] = DA_PKW(P1, 8), pw3[1] = DA_PKW(P1, 10), pw3); \
    DA_GAPA(7, C1 = __builtin_amdgcn_mfma_f32_32x32x16_bf16(kf[7], qr[3], C1, 0, 0, 0),     P1[14], P1[15], 0.f, 0.f,       pw3[2] = DA_PKW(P1, 12), pw3[3] = DA_PKW(P1, 14), pw3); \
    l_reg += sacc; \
    if (GK) { DA_DMA_K((t) + 3, sl_cur); } if (GV) { DA_DMA_V((t) + 1, sl_next); } \
    { float a = max3f(C0[0], C0[1], C1[0]), b = max3f(C0[2], C0[3], C1[1]); a = max3f(a, C1[2], C1[3]); \
      _Pragma("unroll") for (int r = 4; r < 16; r += 4) { a = max3f(a, C0[r], C0[r + 1]); b = max3f(b, C0[r + 2], C0[r + 3]); a = max3f(a, C1[r], C1[r + 1]); b = max3f(b, C1[r + 2], C1[r + 3]); } \
      float rm = __builtin_fmaxf(a, b); { auto rr = __builtin_amdgcn_permlane32_swap(__float_as_uint(rm), __float_as_uint(rm), false, false); rm = __builtin_fmaxf(__uint_as_float(rr[0]), __uint_as_float(rr[1])); } \
      resc = false; \
      if (__builtin_expect(__any(rm - mhat > (float)THRL), 0)) { const float mn = __builtin_fmaxf(mhat, rm); fres = __builtin_amdgcn_exp2f(mhat - mn); l_reg *= fres; mhat = mn; resc = true; } } \
    ATT_SBAR(); \
    DA_GAPB(0,  DA_PAF(0), C0, 0,  true, -1); \
    DA_GAPB(1,  DA_PAF(0), C0, 2,  true, -1); \
    DA_GAPB(2,  DA_PAF(0), C0, 4,  true, -1); \
    DA_GAPB(3,  DA_PAF(0), C0, 6,  true, 0); \
    DA_GAPB(4,  DA_PAF(1), C0, 8,  true, 1); \
    DA_GAPB(5,  DA_PAF(1), C0, 10, true, 2); \
    DA_GAPB(6,  DA_PAF(1), C0, 12, true, 3); \
    DA_GAPB(7,  DA_PAF(1), C0, 14, true, -1); \
    DA_GAPB(8,  DA_PAF(2), C1, 0,  false, -1); \
    DA_GAPB(9,  DA_PAF(2), C1, 2,  false, -1); \
    DA_GAPB(10, DA_PAF(2), C1, 4,  false, -1); \
    DA_GAPB(11, DA_PAF(2), C1, 6,  false, -1); \
    DA_GAPB(12, DA_PAF(3), C1, 8,  false, -1); \
    DA_GAPB(13, DA_PAF(3), C1, 10, false, -1); \
    DA_GAPB(14, DA_PAF(3), C1, 12, false, -1); \
    DA_GAPB(15, DA_PAF(3), C1, 14, false, -1); \
    } while (0)
  int t = 1;
  for (; t + 5 < NT; t += 2) {
    DA_STEP(pB0, pB1, pA0, pA1, t, true, true, true);         ATT_WAIT_BAR(3); DA_RESC(); DA_ROT();
    DA_STEP(pA0, pA1, pB0, pB1, t + 1, true, true, true);     ATT_WAIT_BAR(3); DA_RESC(); DA_ROT();
  }
  DA_STEP(pB0, pB1, pA0, pA1, t, true, true, true);           ATT_WAIT_BAR(3); DA_RESC(); DA_ROT();
  DA_STEP(pA0, pA1, pB0, pB1, t + 1, true, true, true);       ATT_WAIT_BAR(3); DA_RESC(); DA_ROT();
  DA_STEP(pB0, pB1, pA0, pA1, t + 2, false, true, true);      ATT_WAIT_BAR(2); DA_RESC(); DA_ROT();
  DA_STEP(pA0, pA1, pB0, pB1, t + 3, false, true, true);      ATT_WAIT_BAR(0); DA_RESC(); DA_ROT();
  DA_STEP(pB0, pB1, pA0, pA1, t + 4, false, false, false);    DA_RESC();
  { float sacc = pB0[0] + pB0[1];
#pragma unroll
    for (int r = 2; r < 16; ++r) sacc += pB0[r];
#pragma unroll
    for (int r = 0; r < 16; ++r) sacc += pB1[r];
    l_reg += sacc;
    pw0 = (u32x4){DA_PKW(pB0, 0), DA_PKW(pB0, 2), DA_PKW(pB0, 4), DA_PKW(pB0, 6)}; pw1 = (u32x4){DA_PKW(pB0, 8), DA_PKW(pB0, 10), DA_PKW(pB0, 12), DA_PKW(pB0, 14)};
    pw2 = (u32x4){DA_PKW(pB1, 0), DA_PKW(pB1, 2), DA_PKW(pB1, 4), DA_PKW(pB1, 6)}; pw3 = (u32x4){DA_PKW(pB1, 8), DA_PKW(pB1, 10), DA_PKW(pB1, 12), DA_PKW(pB1, 14)};
    const lds_cptr vp_ = vp0 + 2 * sl_cur;
#pragma unroll
    for (int n = 0; n < 16; ++n) {
      const s16x4 lo = vtr(vp_ + ((n & 3) * 4096 + (n >> 2) * 1024)), hh = vtr(vp_ + ((n & 3) * 4096 + (n >> 2) * 1024 + 512));
      const bf16x8 vf = (bf16x8){lo[0], lo[1], lo[2], lo[3], hh[0], hh[1], hh[2], hh[3]};
      const bf16x8 pf = (n >> 2) == 0 ? DA_PAF(0) : (n >> 2) == 1 ? DA_PAF(1) : (n >> 2) == 2 ? DA_PAF(2) : DA_PAF(3);
      o[n & 3] = __builtin_amdgcn_mfma_f32_32x32x16_bf16(vf, pf, o[n & 3], 0, 0, 0); } }
  { auto rr = __builtin_amdgcn_permlane32_swap(__float_as_uint(l_reg), __float_as_uint(l_reg), false, false); l_reg = __uint_as_float(rr[0]) + __uint_as_float(rr[1]); }
  l_out = l_reg;
  asm volatile("s_waitcnt lgkmcnt(0)\n\ts_barrier" ::: "memory");
#undef DA_DMA_K
#undef DA_DMA_V
#undef DA_ROT
#undef DA_RESC
#undef DA_PKW
#undef DA_PAF
#undef DA_VFR
#undef DA_VRD
#undef DA_GAPA
#undef DA_EX
#undef DA_GAPB
#undef DA_STEP
}
}

constexpr int NWAVES = 8;
constexpr int SEQ = 16384, DM = 1024, DEPTH = 2, DIN = 3840, NGATE = 3072, DFF = 2816, NUP = 2 * DFF;
constexpr float LN_EPS = 1e-5f;
constexpr float ALPHA = 1.4142135623730951f;
constexpr int NPHASE = 1 + 9 * DEPTH;

constexpr size_t MiB = 1u << 20;
constexpr size_t WS_CTL = 0, CTL_ZERO_BYTES = 1 * MiB;
constexpr size_t WS_COS = 1 * MiB, WS_SIN = 3 * MiB;
constexpr size_t WS_W = 5 * MiB, W_LAYER = 35 * MiB;
constexpr size_t WO_IN = 0, WO_G = 7864320, WO_BR = WO_G + 6 * MiB, WO_O = WO_BR + 3 * MiB, WO_UP = WO_O + 2 * MiB, WO_DN = WO_UP + 11 * MiB;
static_assert(WO_DN + (size_t)DM * DFF * 2 <= W_LAYER, "weight map");
constexpr size_t WS_HA = 75 * MiB;
constexpr size_t WS_YS = 107 * MiB;
constexpr size_t WS_HP = 107 * MiB;
constexpr int HP_ROWS = 1 + SEQ + 127;
constexpr size_t WS_R1 = 155 * MiB;
constexpr size_t WS_U = WS_R1, WS_DK = WS_R1 + 16 * MiB, WS_DV = WS_R1 + 32 * MiB, WS_SK = WS_R1 + 48 * MiB, WS_SV = WS_R1 + 52 * MiB;
constexpr size_t WS_GT = WS_R1;
constexpr size_t WS_ACT = WS_R1;
constexpr size_t WS_SCR = 211 * MiB;
constexpr size_t WS_END = 251 * MiB;
static_assert(WS_HP + (size_t)HP_ROWS * DM * 2 <= WS_R1 && WS_GT + (size_t)SEQ * NGATE * 2 <= WS_END && WS_SCR + 32 * MiB <= WS_END && WS_SV + 4 * MiB <= WS_SCR, "d_ws map");

constexpr int CW_BAR = 4096;
constexpr int RING_OFF = 0, RING_BYTES = 131072, XLDS_OFF = RING_BYTES, XLDS_BYTES = 8192, LDSCTL_OFF = XLDS_OFF + XLDS_BYTES, MISC_OFF = LDSCTL_OFF + 320;
constexpr int LDS_BYTES = 147456;
static_assert(MISC_OFF + 128 <= LDS_BYTES, "LDS map");

#define GAS __attribute__((address_space(1)))
#define LAS __attribute__((address_space(3)))
typedef unsigned short bf16;
typedef unsigned v4u __attribute__((ext_vector_type(4)));
typedef unsigned v2u __attribute__((ext_vector_type(2)));
typedef float f32x4 __attribute__((ext_vector_type(4)));
#define RLX_AGENT __ATOMIC_RELAXED, __HIP_MEMORY_SCOPE_AGENT
#define LDS_WAIT() asm volatile("s_waitcnt lgkmcnt(0)" ::: "memory")
#define VM_WAIT() asm volatile("s_waitcnt vmcnt(0)" ::: "memory")
__device__ __forceinline__ unsigned f2bf(float f) { unsigned u = __builtin_bit_cast(unsigned, f); return (u + 0x7fffu + ((u >> 16) & 1u)) >> 16; }
__device__ __forceinline__ unsigned pk2(float lo, float hi) { return f2bf(lo) | (f2bf(hi) << 16); }

#define XB_TMO      128
#define XB_XCNT(j)  (256  + 64 * (j))
#define XB_XSUB(j)  (1280 + 64 * (j))
#define XB_XGEN(j)  (2304 + 64 * (j))
#define XB_TOP      3328
#define XB_TOPGEN   3392
#define XCD_BAR_WORDS 3456
#define XB_SPIN_CAP (1u << 22)
__device__ __forceinline__ unsigned xb_ld(unsigned* p)              { return __hip_atomic_load(p, __ATOMIC_RELAXED, __HIP_MEMORY_SCOPE_AGENT); }
__device__ __forceinline__ unsigned xb_add(unsigned* p, unsigned v) { return __hip_atomic_fetch_add(p, v, __ATOMIC_RELAXED, __HIP_MEMORY_SCOPE_AGENT); }
__device__ __forceinline__ unsigned xb_xcc_id() { return (unsigned)__builtin_amdgcn_s_getreg((3 << 11) | 20) & 0xFu; }
#define XB_SPIN(cond, bar) do { unsigned _sp = 0; while (cond) { __builtin_amdgcn_s_sleep(1); \
    if ((++_sp & 255u) == 0u) { if (xb_ld(&(bar)[XB_TMO])) break; if (_sp > XB_SPIN_CAP) { atomicAdd(&(bar)[XB_TMO], 1u); break; } } } } while (0)
struct XcdBarrier { unsigned* bar; unsigned x; volatile LAS unsigned* st; };
__device__ __forceinline__ XcdBarrier xcd_barrier_post(unsigned* bar, volatile LAS unsigned* st) {
    XcdBarrier b; b.bar = bar; b.x = xb_xcc_id(); b.st = st;
    if (threadIdx.x == 0) (void)xb_add(&bar[XB_XCNT(b.x)], 1u);
    return b;
}
__device__ __forceinline__ void xcd_barrier_complete(unsigned* bar, unsigned x, unsigned& nloc, unsigned& nx) {
    const unsigned G = gridDim.x * gridDim.y * gridDim.z;
    unsigned sum, cnt, mine, sp = 0u;
    for (;;) {
        sum = 0u; cnt = 0u; mine = 0u;
#pragma unroll
        for (unsigned j = 0; j < 16; ++j) { const unsigned c = xb_ld(&bar[XB_XCNT(j)]); sum += c; cnt += (c > 0u) ? 1u : 0u; mine = (j == x) ? c : mine; }
        if (sum == G) break;
        __builtin_amdgcn_s_sleep(1);
        if ((++sp & 255u) == 0u) { if (xb_ld(&bar[XB_TMO])) break; if (sp > XB_SPIN_CAP) { atomicAdd(&bar[XB_TMO], 1u); break; } }
    }
    nloc = mine > 0u ? mine : 1u; nx = cnt > 0u ? cnt : 1u;
}
__device__ __forceinline__ void xcd_barrier(const XcdBarrier& b) {
    asm volatile("s_waitcnt vmcnt(0)" ::: "memory");
    __syncthreads();
    if (threadIdx.x == 0) {
        unsigned* bar = b.bar;
        __builtin_amdgcn_s_waitcnt(0);
        unsigned nloc = b.st[0], nx = b.st[1];
        if (nloc == 0u) { xcd_barrier_complete(bar, b.x, nloc, nx); b.st[0] = nloc; b.st[1] = nx; }
        const unsigned old = xb_add(&bar[XB_XSUB(b.x)], 1u);
        const unsigned gen = old / nloc;
        if (old + 1u == (gen + 1u) * nloc) {
            __builtin_amdgcn_fence(__ATOMIC_RELEASE, "agent");
            asm volatile("s_waitcnt vmcnt(0)" ::: "memory");
            const unsigned og = xb_add(&bar[XB_TOP], 1u);
            const unsigned tg = og / nx;
            if (og + 1u == (tg + 1u) * nx) xb_add(&bar[XB_TOPGEN], 1u);
            else XB_SPIN(xb_ld(&bar[XB_TOPGEN]) == tg, bar);
            __builtin_amdgcn_fence(__ATOMIC_ACQUIRE, "agent");
            xb_add(&bar[XB_XGEN(b.x)], 1u);
            asm volatile("s_waitcnt vmcnt(0)" ::: "memory");
        } else {
            XB_SPIN(xb_ld(&bar[XB_XGEN(b.x)]) == gen, bar);
            __builtin_amdgcn_fence(__ATOMIC_ACQUIRE, "agent");
            asm volatile("s_waitcnt vmcnt(0)" ::: "memory");
        }
    }
    __syncthreads();
}

__device__ __forceinline__ float wave_sum(float v) {
#pragma unroll
    for (int o = 1; o < 64; o <<= 1) v += __shfl_xor(v, o);
    return v;
}
__device__ __forceinline__ void conv_item(const float* W, int ldw, int k0, int srcc, bf16* WT, int ldt, int dstr, int dstk, LAS float* scr, int lane) {
#pragma unroll 8
    for (int i = 0; i < 32; ++i) { const int kk = 2 * i + (lane >> 5); scr[kk * 33 + (lane & 31)] = W[(size_t)(k0 + kk) * ldw + srcc + (lane & 31)]; }
    LDS_WAIT(); asm volatile("" ::: "memory");
    const int c = lane & 7;
#pragma unroll
    for (int j = 0; j < 4; ++j) { const int n = (lane >> 3) + 8 * j; const LAS float* s = scr + (8 * c) * 33 + n;
        v4u o; o.x = pk2(s[0 * 33], s[1 * 33]); o.y = pk2(s[2 * 33], s[3 * 33]); o.z = pk2(s[4 * 33], s[5 * 33]); o.w = pk2(s[6 * 33], s[7 * 33]);
        *(GAS v4u*)(WT + (size_t)(dstr + n) * ldt + dstk + 8 * c) = o; }
    LDS_WAIT(); asm volatile("" ::: "memory");
}
__device__ __forceinline__ int inmap(int gd) {
    const int tile = gd >> 3, bj = (gd >> 2) & 1, wc = gd & 3;
    if (tile < 4)  return (bj ? 1024 : 0) + 128 * tile + 32 * wc;
    if (tile < 6)  return 512 + 32 * (gd - 32);
    if (tile < 8)  return 1536 + (4 * (tile - 6) + wc) * 64 + 32 * bj;
    if (tile < 10) return 2048 + (4 * (tile - 8) + wc) * 64 + 32 * bj;
    if (tile < 12) return 2560 + 32 * (gd - 80);
    if (tile < 14) return 3072 + (4 * (tile - 12) + wc) * 64 + 32 * bj;
    return (wc < 2) ? 3584 + wc * 64 + 32 * bj : 3712 + 64 * bj + 32 * (wc - 2);
}
__device__ __forceinline__ int upmap(int gd) { const int tile = gd >> 3, bj = (gd >> 2) & 1, wc = gd & 3; return (bj ? DFF : 0) + 128 * tile + 32 * wc; }

__device__ __forceinline__ void ln_row(const float* src, const float* g, const float* b, float* dst32, bf16* dst16, int lane) {
    const f32x4* xr = (const f32x4*)src + lane;
    f32x4 v[4]; float s = 0.f;
#pragma unroll
    for (int j = 0; j < 4; ++j) { v[j] = xr[64 * j]; s += (v[j].x + v[j].y) + (v[j].z + v[j].w); }
    const float mean = wave_sum(s) * (1.f / DM); float s2 = 0.f;
#pragma unroll
    for (int j = 0; j < 4; ++j) { v[j] = v[j] - mean; s2 += (v[j].x * v[j].x + v[j].y * v[j].y) + (v[j].z * v[j].z + v[j].w * v[j].w); }
    const float rstd = 1.f / sqrtf(wave_sum(s2) * (1.f / DM) + LN_EPS);
#pragma unroll
    for (int j = 0; j < 4; ++j) { const f32x4 gg = ((const f32x4*)g)[lane + 64 * j], bb = ((const f32x4*)b)[lane + 64 * j];
        const f32x4 y = v[j] * rstd * gg + bb;
        ((f32x4*)dst32)[lane + 64 * j] = y;
        v2u w; w.x = pk2(y.x, y.y); w.y = pk2(y.z, y.w); ((v2u*)dst16)[lane + 64 * j] = w; }
}
__device__ __forceinline__ void sincos_d(double a, double& sn, double& cs) {
    const double q = __builtin_rint(a * 0.63661977236758134308);
    double r = __builtin_fma(-q, 1.57079632679489655800e+00, a); r = __builtin_fma(-q, 6.12323399573676603587e-17, r);
    const double r2 = r * r;
    double s = -7.6471637318198164759e-13; s = s * r2 + 1.6059043836821614599e-10; s = s * r2 - 2.5052108385441718775e-08; s = s * r2 + 2.7557319223985890653e-06;
    s = s * r2 - 1.9841269841269841270e-04; s = s * r2 + 8.3333333333333333333e-03; s = s * r2 - 1.6666666666666666667e-01; s = r + r * r2 * s;
    double c = 4.7794773323873852974e-14; c = c * r2 - 1.1470745597729724714e-11; c = c * r2 + 2.0876756987868098979e-09; c = c * r2 - 2.7557319223985890653e-07;
    c = c * r2 + 2.4801587301587301587e-05; c = c * r2 - 1.3888888888888888889e-03; c = c * r2 + 4.1666666666666666667e-02; c = c * r2 - 0.5; c = c * r2 + 1.0;
    const int qi = (int)((long long)q & 3);
    sn = (qi == 0) ? s : (qi == 1) ? c : (qi == 2) ? -s : -c;
    cs = (qi == 0) ? c : (qi == 1) ? -s : (qi == 2) ? -c : s;
}
__device__ __forceinline__ float rope_theta_pow(int i) {
    constexpr double T[32] = {1, 1.333521432163324, 1.7782794100389228, 2.3713737056616551, 3.1622776601683795, 4.2169650342858223, 5.6234132519034912, 7.4989420933245583, 10, 13.33521432163324,
        17.782794100389228, 23.713737056616552, 31.622776601683793, 42.169650342858226, 56.234132519034908, 74.989420933245583, 100, 133.35214321633239, 177.82794100389228, 237.13737056616552,
        316.22776601683796, 421.69650342858228, 562.34132519034904, 749.89420933245583, 1000, 1333.5214321633241, 1778.2794100389228, 2371.3737056616551, 3162.2776601683795, 4216.9650342858222,
        5623.4132519034911, 7498.9420933245583};
    return (float)T[i];
}

#ifndef MK_DIAG
#define MK_DIAG -1
#endif
#define PH_EN(k) ((MK_DIAG) < 0 || (MK_DIAG) == (k))
#ifndef ATT_SD
#define ATT_SD 1
#endif
struct Params { const float* in[20]; float* out; unsigned char* ws; int ph_lo, ph_hi, li, pad; };
enum { I_X = 0, I_POS, I_LNG, I_LNB, I_WIN, I_CONVW, I_DLAM, I_SUBG, I_SINK, I_WGATE, I_BGATE, I_WBR, I_WO, I_LMG, I_LMB, I_WUP, I_FCW, I_WDN, I_LFG, I_LFB };

template <int SUB>
__device__ __forceinline__ void run_phase(const int l, const int wave_s, LAS unsigned char* L, unsigned char* lds) {
        int lane_; asm volatile("v_mbcnt_lo_u32_b32 %0, -1, 0\n\tv_mbcnt_hi_u32_b32 %0, -1, %0" : "=v"(lane_));
        int bx = blockIdx.x, G = gridDim.x, wave = wave_s;
        asm volatile("" : "+s"(bx)); asm volatile("" : "+s"(G)); asm volatile("" : "+s"(wave));
        const int lane = lane_, tid = wave * 64 + lane_;
        const int vcu = (G % 8 == 0) ? (bx % 8) * (G / 8) + bx / 8 : bx;
        const int gw = vcu * NWAVES + wave, NGW = G * NWAVES;
        const __attribute__((address_space(4))) Params* pp = (const __attribute__((address_space(4))) Params*)__builtin_amdgcn_kernarg_segment_ptr();
        asm volatile("" : "+s"(pp));
#define PIN(i) (pp->in[i])
        unsigned char* ws = pp->ws;
        float* H32 = pp->out;
        float* COS = (float*)(ws + WS_COS); float* SIN = (float*)(ws + WS_SIN);
        bf16* HA = (bf16*)(ws + WS_HA); bf16* YS = (bf16*)(ws + WS_YS); bf16* HP = (bf16*)(ws + WS_HP);
        bf16* UB = (bf16*)(ws + WS_U); bf16* DKB = (bf16*)(ws + WS_DK); bf16* DVB = (bf16*)(ws + WS_DV); bf16* SKB = (bf16*)(ws + WS_SK); bf16* SVB = (bf16*)(ws + WS_SV);
        bf16* GT = (bf16*)(ws + WS_GT); bf16* ACT = (bf16*)(ws + WS_ACT); float* SCR = (float*)(ws + WS_SCR);
        unsigned char* wl = ws + WS_W + (size_t)l * W_LAYER;
        (void)lane; (void)gw; (void)NGW; (void)H32; (void)COS; (void)SIN; (void)HA; (void)YS; (void)HP; (void)UB; (void)DKB; (void)DVB; (void)SKB; (void)SVB; (void)GT; (void)ACT; (void)SCR; (void)wl; (void)vcu;
        if constexpr (SUB == -1) {
            LAS float* scr = (LAS float*)(L + RING_OFF + wave * 16384);
            constexpr int N_IN = 16 * 120, N_G = 16 * 96, N_BR = 3 * 8 * 32, N_O = 16 * 32, N_UP = 16 * 176, N_DN = 44 * 32, N_L = N_IN + N_G + N_BR + N_O + N_UP + N_DN;
            for (int it = gw; it < DEPTH * N_L; it += NGW) {
                const int ll = it / N_L; int r = it - ll * N_L; unsigned char* wb = ws + WS_W + (size_t)ll * W_LAYER;
                if (r < N_IN) { const int kb = r / 120, gd = r % 120; conv_item(PIN(I_WIN) + (size_t)ll * DM * DIN, DIN, kb * 64, inmap(gd), (bf16*)(wb + WO_IN), DM, gd * 32, kb * 64, scr, lane); continue; } r -= N_IN;
                if (r < N_G) { const int kb = r / 96, gd = r % 96; conv_item(PIN(I_WGATE) + (size_t)ll * DM * NGATE, NGATE, kb * 64, gd * 32, (bf16*)(wb + WO_G), DM, gd * 32, kb * 64, scr, lane); continue; } r -= N_G;
                if (r < N_BR) { const int n = r / 256, rr = r % 256, kb = rr / 32, gd = rr % 32; conv_item(PIN(I_WBR) + (size_t)(ll * 3 + n) * 512 * DM, DM, kb * 64, gd * 32, (bf16*)(wb + WO_BR), 1536, gd * 32, n * 512 + kb * 64, scr, lane); continue; } r -= N_BR;
                if (r < N_O) { const int kb = r / 32, gd = r % 32; conv_item(PIN(I_WO) + (size_t)ll * DM * DM, DM, kb * 64, gd * 32, (bf16*)(wb + WO_O), DM, gd * 32, kb * 64, scr, lane); continue; } r -= N_O;
                if (r < N_UP) { const int kb = r / 176, gd = r % 176; conv_item(PIN(I_WUP) + (size_t)ll * DM * NUP, NUP, kb * 64, upmap(gd), (bf16*)(wb + WO_UP), DM, gd * 32, kb * 64, scr, lane); continue; } r -= N_UP;
                { const int kb = r / 32, gd = r % 32; conv_item(PIN(I_WDN) + (size_t)ll * DFF * DM, DM, kb * 64, gd * 32, (bf16*)(wb + WO_DN), DFF, gd * 32, kb * 64, scr, lane); }
            }
            const int* pos = (const int*)PIN(I_POS);
            for (int idx = vcu * 512 + tid; idx < SEQ * 32; idx += G * 512) {
                const int t = idx >> 5, i = idx & 31;
                const float inv = 1.0f / rope_theta_pow(i);
                const float ang = (float)pos[t] * inv;
                double sd, cd; sincos_d((double)ang, sd, cd);
                COS[idx] = (float)cd; SIN[idx] = (float)sd;
            }
            for (int m = gw; m < SEQ; m += NGW) ln_row(PIN(I_X) + (size_t)m * DM, PIN(I_LNG), PIN(I_LNB), H32 + (size_t)m * DM, HA + (size_t)m * DM, lane);
        } else if constexpr (SUB == 0) {
            pg8::Gemm g{HA, (const bf16*)(wl + WO_IN), DM, DM, DM}; pg8::StaticOrder S; S.init(SEQ / 256, DIN / 256, G, bx, 256);
            pg8::EpiInProj E{UB, YS, DKB, DVB, SKB, SVB, COS, SIN};
            pg8::gemm_phase<pg8::EpiInProj, pg8::StaticOrder, true>(tid, L + RING_OFF, L + XLDS_OFF, g, S, E);
        } else if constexpr (SUB == 1) {
            char* al = (char*)lds;
            const int r32 = lane & 31, hi = lane >> 5;
            const float lambda_init = (l == 0) ? 0.2f : 0.35550906759096934f;
#ifndef MK_NO_DIFF
            for (int pair = vcu; pair < 256; pair += G) {
                const int h = pair >> 6, qb = pair & 63;
                att::f32x16 o[4]; float lsum;
#define FRESH_LANE(v) int v; asm volatile("v_mbcnt_lo_u32_b32 %0, -1, 0\n\tv_mbcnt_hi_u32_b32 %0, -1, %0" : "=v"(v))
                { FRESH_LANE(la); const size_t qrow = (size_t)qb * 256 + wave * 32 + (la & 31);
                  att::attn_diff_core<512, 512, 8>(wave * 64 + la, YS + qrow * 1536 + 512 + h * 128 + (la >> 5) * 8, DKB + h * 128, DVB + h * 128, SEQ / 64, al, o, lsum); }
                { FRESH_LANE(lb); f32x4* scr = (f32x4*)(SCR + ((size_t)(pair * 8 + wave) * 64 + lb) * 64);
                  const float rl = 1.0f / lsum;
#pragma unroll
                  for (int d = 0; d < 4; ++d)
#pragma unroll
                      for (int g4 = 0; g4 < 4; ++g4) scr[d * 4 + g4] = (f32x4){o[d][4 * g4] * rl, o[d][4 * g4 + 1] * rl, o[d][4 * g4 + 2] * rl, o[d][4 * g4 + 3] * rl}; }
                __syncthreads();
                { FRESH_LANE(lc); const size_t qrow = (size_t)qb * 256 + wave * 32 + (lc & 31);
                  att::attn_diff_core<512, 512, 8>(wave * 64 + lc, YS + qrow * 1536 + 512 + h * 128 + 64 + (lc >> 5) * 8, DKB + h * 128 + 64, DVB + h * 128, SEQ / 64, al, o, lsum); }
                { FRESH_LANE(ld); const int hi2 = ld >> 5; const size_t qrow = (size_t)qb * 256 + wave * 32 + (ld & 31);
                  const f32x4* scr = (const f32x4*)(SCR + ((size_t)(pair * 8 + wave) * 64 + ld) * 64);
                  const float* lp = PIN(I_DLAM) + l * 256;
                  const float s01 = wave_sum(lp[ld] * lp[64 + ld]), s23 = wave_sum(lp[128 + ld] * lp[192 + ld]);
                  const float lam = __builtin_amdgcn_exp2f(s01 * 1.4426950408889634f) - __builtin_amdgcn_exp2f(s23 * 1.4426950408889634f) + lambda_init;
                  const float rl1 = lam / lsum; float ss = 0.f;
                  VM_WAIT();
#pragma unroll
                  for (int d = 0; d < 4; ++d)
#pragma unroll
                      for (int g4 = 0; g4 < 4; ++g4) { const f32x4 sv = scr[d * 4 + g4];
#pragma unroll
                          for (int e = 0; e < 4; ++e) { const float y = sv[e] - o[d][4 * g4 + e] * rl1; o[d][4 * g4 + e] = y; ss += y * y; } }
                  { auto rr = __builtin_amdgcn_permlane32_swap(__float_as_uint(ss), __float_as_uint(ss), false, false); ss = __uint_as_float(rr[0]) + __uint_as_float(rr[1]); }
                  const float rms = (1.0f - lambda_init) / sqrtf(ss * (1.0f / 128.0f) + LN_EPS);
                  const float* sg = PIN(I_SUBG) + l * 128;
                  bf16* op = YS + qrow * 1536 + 512 + h * 128;
#pragma unroll
                  for (int d = 0; d < 4; ++d)
#pragma unroll
                      for (int g4 = 0; g4 < 4; ++g4) { const int dc = 32 * d + 8 * g4 + 4 * hi2; const f32x4 gg = *(const f32x4*)(sg + dc);
                          v2u w; w.x = pk2(o[d][4 * g4] * rms * gg.x, o[d][4 * g4 + 1] * rms * gg.y); w.y = pk2(o[d][4 * g4 + 2] * rms * gg.z, o[d][4 * g4 + 3] * rms * gg.w);
                          *(v2u*)(op + dc) = w; } }
                __syncthreads();
            }
#endif
#ifndef MK_NO_SWA
            {
            int ln2_; asm volatile("v_mbcnt_lo_u32_b32 %0, -1, 0\n\tv_mbcnt_hi_u32_b32 %0, -1, %0" : "=v"(ln2_));
            int wv2_ = wave_s; asm volatile("" : "+s"(wv2_));
            const int lane = ln2_, wave = wv2_, tid = wv2_ * 64 + ln2_, r32 = ln2_ & 31, hi = ln2_ >> 5;
            for (int su = vcu; su < 512; su += G) {
                const int hq = su >> 6, qb = su & 63, q0 = qb * 256, kvh = hq >> 2;
                const int ks = (q0 - 128 < 0) ? 0 : q0 - 128, ke = (q0 + 384 > SEQ) ? SEQ : q0 + 384, NT = (ke - ks) / 64;
                const int qpos = q0 + wave * 32 + r32;
                att::f32x16 o[2]; float lsum;
                att::attn_core<64, true, 128, 128>(tid, YS + (size_t)qpos * 1536 + 1024 + hq * 64 + hi * 8, SKB + (size_t)ks * 128 + kvh * 64, SVB + (size_t)ks * 128 + kvh * 64, NT,
                                         PIN(I_SINK)[l * 8 + hq] * 8.0f, 1.0f, ks - qpos, 128, al, o, lsum);
                const float rl = 1.0f / lsum;
                bf16* op = YS + (size_t)qpos * 1536 + 1024 + hq * 64;
#pragma unroll
                for (int d = 0; d < 2; ++d)
#pragma unroll
                    for (int g4 = 0; g4 < 4; ++g4) { const int dc = 32 * d + 8 * g4 + 4 * hi;
                        v2u w; w.x = pk2(o[d][4 * g4] * rl, o[d][4 * g4 + 1] * rl); w.y = pk2(o[d][4 * g4 + 2] * rl, o[d][4 * g4 + 3] * rl);
                        *(v2u*)(op + dc) = w; }
                __syncthreads();
            }
            }
#endif
            const float* cw = PIN(I_CONVW) + l * 3 * 512;
            int ln3_; asm volatile("v_mbcnt_lo_u32_b32 %0, -1, 0\n\tv_mbcnt_hi_u32_b32 %0, -1, %0" : "=v"(ln3_));
            int wv3_ = wave_s; asm volatile("" : "+s"(wv3_));
            const int tid3 = wv3_ * 64 + ln3_;
            for (int idx = vcu * 512 + tid3; idx < SEQ * 64; idx += G * 512) {
                const int t = idx >> 6, c8 = (idx & 63) * 8;
                const v4u z = {0u, 0u, 0u, 0u};
                const v4u uc = *(const v4u*)(UB + (size_t)t * 512 + c8);
                const v4u up = (t > 0) ? *(const v4u*)(UB + (size_t)(t - 1) * 512 + c8) : z;
                const v4u un = (t < SEQ - 1) ? *(const v4u*)(UB + (size_t)(t + 1) * 512 + c8) : z;
                const v4u ab = *(const v4u*)(YS + (size_t)t * 1536 + c8);
                f32x4 ca, cb, pa, pb, na, nb, ba, bb; pg8::unpack8(uc, ca, cb); pg8::unpack8(up, pa, pb); pg8::unpack8(un, na, nb); pg8::unpack8(ab, ba, bb);
                const f32x4 w0a = *(const f32x4*)(cw + c8), w0b = *(const f32x4*)(cw + c8 + 4), w1a = *(const f32x4*)(cw + 512 + c8), w1b = *(const f32x4*)(cw + 512 + c8 + 4);
                const f32x4 w2a = *(const f32x4*)(cw + 1024 + c8), w2b = *(const f32x4*)(cw + 1024 + c8 + 4);
                const f32x4 ya = ba * (w0a * pa + w1a * ca + w2a * na), yb = bb * (w0b * pb + w1b * cb + w2b * nb);
                *(v4u*)(YS + (size_t)t * 1536 + c8) = pg8::pack8(ya, yb);
            }
        } else if constexpr (SUB == 2) {
            pg8::Gemm g{HA, (const bf16*)(wl + WO_G), DM, DM, DM}; pg8::StaticOrder S; S.init(SEQ / 256, NGATE / 256, G, bx, 256);
            pg8::EpiGates E{GT, PIN(I_BGATE) + l * NGATE};
            pg8::gemm_phase<pg8::EpiGates, pg8::StaticOrder, true>(tid, L + RING_OFF, L + XLDS_OFF, g, S, E);
        } else if constexpr (SUB == 3) {
            pg8::Gemm g{YS, (const bf16*)(wl + WO_BR), 1536, 1536, 512}; pg8::SegOrder S; S.init(SEQ / 256, DM / 256, G, bx, 3, 512);
            pg8::EpiBranch E{HA, GT};
            pg8::gemm_phase<pg8::EpiBranch, pg8::SegOrder, true>(tid, L + RING_OFF, L + XLDS_OFF, g, S, E);
        } else if constexpr (SUB == 4 || SUB == 7) {
            pg8::Gemm g{(SUB == 4) ? HA : ACT, (const bf16*)(wl + ((SUB == 4) ? WO_O : WO_DN)), (SUB == 4) ? DM : DFF, (SUB == 4) ? DM : DFF, (SUB == 4) ? DM : DFF};
            pg8::StaticOrder S; S.init(SEQ / 256, DM / 256, G, bx, 256);
            pg8::EpiResid E{H32, ALPHA};
            pg8::gemm_phase<pg8::EpiResid, pg8::StaticOrder, true>(tid, L + RING_OFF, L + XLDS_OFF, g, S, E);
        } else if constexpr (SUB == 5 || SUB == 8) {
            const float* gg = PIN((SUB == 5) ? I_LMG : I_LFG) + l * DM; const float* bb = PIN((SUB == 5) ? I_LMB : I_LFB) + l * DM;
            bf16* dst = (SUB == 5) ? HP + DM : HA;
            for (int m = gw; m < SEQ; m += NGW) ln_row(H32 + (size_t)m * DM, gg, bb, H32 + (size_t)m * DM, dst + (size_t)m * DM, lane);
            if (SUB == 5) {
                for (int idx = vcu * 512 + tid; idx < 128 * (DM / 8); idx += G * 512) { const int rr = idx / (DM / 8), c8 = (idx % (DM / 8)) * 8; const int row = (rr == 0) ? 0 : SEQ + rr;
                    *(v4u*)(HP + (size_t)row * DM + c8) = (v4u){0u, 0u, 0u, 0u}; }
            }
        } else if constexpr (SUB == 9) {
#ifdef MK_DUMP
            for (int idx = vcu * 512 + tid; idx < SEQ * 128; idx += G * 512) {
                const int t = idx >> 7, c8 = (idx & 127) * 8;
                const bf16* src;
                if (MK_DUMP == 1) src = YS + (size_t)t * 1536 + c8;
                else if (MK_DUMP == 2) src = YS + (size_t)t * 1536 + 512 + c8;
                else if (MK_DUMP == 3) src = UB + (size_t)t * 512 + (c8 & 511);
                else if (MK_DUMP == 4) src = (c8 < 512) ? DKB + (size_t)t * 512 + c8 : DVB + (size_t)t * 512 + (c8 - 512);
                else if (MK_DUMP == 5) src = (c8 < 512) ? SKB + (size_t)t * 128 + (c8 & 127) : SVB + (size_t)t * 128 + (c8 & 127);
                else if (MK_DUMP == 6) src = GT + (size_t)t * 3072 + c8;
                else if (MK_DUMP == 7) src = GT + (size_t)t * 3072 + 1024 + c8;
                else if (MK_DUMP == 8) src = GT + (size_t)t * 3072 + 2048 + c8;
                else src = HA + (size_t)t * 1024 + c8;
                const v4u w = *(const v4u*)src; f32x4 a, b; pg8::unpack8(w, a, b);
                *(f32x4*)(H32 + (size_t)t * 1024 + c8) = a; *(f32x4*)(H32 + (size_t)t * 1024 + c8 + 4) = b;
            }
#endif
        } else if constexpr (SUB == 6) {
            pg8::Gemm g{HP, (const bf16*)(wl + WO_UP), DM, DM, DM}; pg8::StaticOrder S; S.init(65, NUP / 256, G, bx, 254);
            pg8::EpiUpConv E{ACT, PIN(I_FCW) + (size_t)l * 3 * NUP};
            pg8::gemm_phase<pg8::EpiUpConv, pg8::StaticOrder, true>(tid, L + RING_OFF, L + XLDS_OFF, g, S, E);
        }
#undef PIN
}

__global__ void __launch_bounds__(NWAVES * 64, 2) mk_fwd(Params p) {
    extern __shared__ __attribute__((aligned(16))) unsigned char lds[];
    LAS unsigned char* L = (LAS unsigned char*)lds;
    volatile LAS unsigned* MISC = (volatile LAS unsigned*)(L + MISC_OFF);
    for (int u = threadIdx.x; u < (LDS_BYTES - LDSCTL_OFF) / 4; u += NWAVES * 64) ((LAS unsigned*)(L + LDSCTL_OFF))[u] = 0u;
    __syncthreads();
    const int wave_s = __builtin_amdgcn_readfirstlane((int)threadIdx.x >> 6);
#if MK_ONE_LAUNCH
    (void)xcd_barrier_post((unsigned*)(p.ws + WS_CTL) + CW_BAR, MISC + 8);
#define GRID_BAR() do { XcdBarrier bar_; bar_.bar = (unsigned*)(((const __attribute__((address_space(4))) Params*)__builtin_amdgcn_kernarg_segment_ptr())->ws + WS_CTL) + CW_BAR; bar_.x = xb_xcc_id(); bar_.st = MISC + 8; xcd_barrier(bar_); } while (0)
    constexpr int lo = 0, hi = NPHASE;
#else
    (void)MISC;
#define GRID_BAR() do {} while (0)
    const int lo = p.ph_lo, hi = p.ph_hi;
#endif
#ifdef MK_LEAK
#define STAMP(k) do { if (blockIdx.x == 0 && threadIdx.x == 0) ((unsigned long long*)(p.ws + WS_CTL))[16 + (k)] = __builtin_amdgcn_s_memrealtime(); } while (0)
#else
#define STAMP(k) do {} while (0)
#endif
#define PH(k, SUBV, lv) if (PH_EN(k) && lo <= (k) && (k) < hi) { STAMP(k); run_phase<SUBV>(lv, wave_s, L, lds); if ((k) + 1 < hi) GRID_BAR(); }
    PH(0, -1, 0)
    PH(1, 0, 0) PH(2, 1, 0) PH(3, 2, 0) PH(4, 3, 0) PH(5, 4, 0) PH(6, 5, 0) PH(7, 6, 0) PH(8, 7, 0) PH(9, 8, 0)
    PH(10, 0, 1) PH(11, 1, 1) PH(12, 2, 1) PH(13, 3, 1) PH(14, 4, 1) PH(15, 5, 1) PH(16, 6, 1) PH(17, 7, 1) PH(18, 8, 1)
#ifdef MK_DUMP
    PH(19, 9, 0)
#endif
#ifdef MK_LEAK
    STAMP(19);
    __syncthreads();
    if (blockIdx.x == 0 && threadIdx.x == 0) { asm volatile("s_waitcnt vmcnt(0)" ::: "memory"); const unsigned long long* st = (const unsigned long long*)(p.ws + WS_CTL) + 16;
        p.out[0] += (float)(st[MK_LEAK_END] - st[MK_LEAK]) * 0.01f * MK_LEAK_SCALE; }
#endif
#undef PH
}

extern "C" void kernel_launch(void* const* d_in, const int* in_sizes, int n_in, void* d_out, int out_size, void* d_ws, size_t ws_size, hipStream_t stream) {
    static int grid = 0;
    if (grid == 0) {
        if (n_in != 20 || in_sizes[0] != SEQ * DM || out_size != SEQ * DM || ws_size < WS_END) { fprintf(stderr, "kernel_launch: shape/workspace mismatch n_in %d in0 %d out %d ws %zu (need %zu)\n", n_in, n_in > 0 ? in_sizes[0] : -1, out_size, ws_size, (size_t)WS_END); grid = -1; return; }
        int dev = 0, cus = 0, per_cu = 0;
        if (hipGetDevice(&dev) != hipSuccess || hipDeviceGetAttribute(&cus, hipDeviceAttributeMultiprocessorCount, dev) != hipSuccess) { grid = -1; return; }
        if (hipFuncSetAttribute((const void*)mk_fwd, hipFuncAttributeMaxDynamicSharedMemorySize, LDS_BYTES) != hipSuccess) { fprintf(stderr, "kernel_launch: hipFuncSetAttribute failed\n"); grid = -1; return; }
        if (hipOccupancyMaxActiveBlocksPerMultiprocessor(&per_cu, (const void*)mk_fwd, NWAVES * 64, LDS_BYTES) != hipSuccess || per_cu < 1) { fprintf(stderr, "kernel_launch: occupancy query says %d blocks per CU\n", per_cu); (void)hipGetLastError(); grid = -1; return; }
        grid = cus;
    }
    if (grid < 0) return;
    if (hipMemsetAsync((char*)d_ws + WS_CTL, 0, CTL_ZERO_BYTES, stream) != hipSuccess) return;
    Params a{};
    for (int i = 0; i < 20; ++i) a.in[i] = (const float*)d_in[i];
    a.out = (float*)d_out; a.ws = (unsigned char*)d_ws; a.li = 0; a.pad = 0;
#if MK_ONE_LAUNCH
    a.ph_lo = 0; a.ph_hi = NPHASE;
    hipLaunchKernelGGL(mk_fwd, dim3(grid), dim3(NWAVES * 64), LDS_BYTES, stream, a);
#else
#ifdef MK_PHLIST
    { const int phl[] = MK_PHLIST; for (int i = 0; i < (int)(sizeof(phl) / sizeof(int)); ++i) { a.ph_lo = phl[i]; a.ph_hi = phl[i] + 1; hipLaunchKernelGGL(mk_fwd, dim3(grid), dim3(NWAVES * 64), LDS_BYTES, stream, a); } }
#else
    for (int ph = 0; ph < NPHASE; ++ph) { a.ph_lo = ph; a.ph_hi = ph + 1; hipLaunchKernelGGL(mk_fwd, dim3(grid), dim3(NWAVES * 64), LDS_BYTES, stream, a); }
#endif
#endif
    const hipError_t le = hipPeekAtLastError();
    if (le != hipSuccess) fprintf(stderr, "kernel_launch: launch failed: %s\n", hipGetErrorName(le));
}
```
